# Optimizing an MI355X kernel written in HIP

```python
import math
import jax, jax.numpy as jnp
from jax import lax
import numpy as np


D_MODEL = 1024
BATCH = 8
SEQ = 4096
DEPTH = 2

N_MIXERS = 2
N_A_LAYERS = (DEPTH + 1) // 2
N_B_LAYERS = DEPTH // 2
Q_BLOCK = 128

SB_HEADS = 16
SB_HEAD_DIM = D_MODEL // SB_HEADS

DSA_HEADS = 16
DSA_LATENT = 128
DSA_V_DIM = D_MODEL // DSA_HEADS
IDX_HEADS = 8
IDX_DIM = 64
TOPK_MAX = 256
DSA_IN = DSA_HEADS * DSA_LATENT + DSA_LATENT + IDX_HEADS * IDX_DIM + IDX_DIM + IDX_HEADS

NUM_BUCKETS = 32
MAX_DISTANCE = 128

FFN_DIM = 2816
CONV_W = 3

RMS_EPS = 1e-6
NEG = -1e30

kernel_name = 'hybrid_stickbreak_dsa_convffn_adaln'


def rms_norm(x, g):
    xf = x.astype(jnp.float32)
    y = xf * lax.rsqrt(jnp.mean(xf * xf, axis=-1, keepdims=True) + RMS_EPS)
    return (y * g.astype(jnp.float32)).astype(x.dtype)


def _blocks(a):
    B, S = a.shape[0], a.shape[1]
    a = a.reshape((B, S // Q_BLOCK, Q_BLOCK) + a.shape[2:])
    return jnp.moveaxis(a, 1, 0)


def _unblocks(a):
    a = jnp.moveaxis(a, 0, 1)
    return a.reshape((a.shape[0], a.shape[1] * a.shape[2]) + a.shape[3:])


def t5_bucket(dist):
    n = jnp.maximum(dist, 0)
    max_exact = NUM_BUCKETS // 2
    nf = jnp.maximum(n, 1).astype(jnp.float32)
    large = max_exact + (jnp.log(nf / max_exact) / math.log(MAX_DISTANCE / max_exact)
                         * (NUM_BUCKETS - max_exact)).astype(jnp.int32)
    large = jnp.minimum(large, NUM_BUCKETS - 1)
    return jnp.where(n < max_exact, n, large)


def stick_breaking_attention(h, w_in, w_out):
    B, S, _ = h.shape
    qkv = h @ w_in
    q, k, v = jnp.split(qkv, 3, axis=-1)
    q = q.reshape(B, S, SB_HEADS, SB_HEAD_DIM).astype(jnp.float32) * (SB_HEAD_DIM ** -0.5)
    k = k.reshape(B, S, SB_HEADS, SB_HEAD_DIM).astype(jnp.float32)
    v = v.reshape(B, S, SB_HEADS, SB_HEAD_DIM).astype(jnp.float32)
    key_pos = jnp.arange(S)

    def block(args):
        qb, t0 = args
        t = t0 + jnp.arange(Q_BLOCK)
        z = jnp.einsum('bqhd,bshd->bhqs', qb, k)
        strict = key_pos[None, :] < t[:, None]
        log_keep = jnp.where(strict, jax.nn.log_sigmoid(-z), 0.0)
        suffix = lax.cumsum(log_keep, axis=3, reverse=True) - log_keep
        a = jnp.where(strict, jnp.exp(jax.nn.log_sigmoid(z) + suffix), 0.0)
        return jnp.einsum('bhqs,bshd->bqhd', a, v)

    starts = jnp.arange(S // Q_BLOCK) * Q_BLOCK
    o = _unblocks(lax.map(block, (_blocks(q), starts)))
    return o.reshape(B, S, SB_HEADS * SB_HEAD_DIM).astype(h.dtype) @ w_out


def dsa_attention(h, w_in, q_gain, k_gain, w_uv, w_out, rel_bias):
    B, S, _ = h.shape
    topk = min(TOPK_MAX, S // 4)
    proj = h @ w_in
    o1 = DSA_HEADS * DSA_LATENT
    o2 = o1 + DSA_LATENT
    o3 = o2 + IDX_HEADS * IDX_DIM
    o4 = o3 + IDX_DIM
    q, lat, qi, ki, wi = jnp.split(proj, [o1, o2, o3, o4], axis=-1)
    q = rms_norm(q.reshape(B, S, DSA_HEADS, DSA_LATENT), q_gain).astype(jnp.float32)
    k = rms_norm(lat, k_gain).astype(jnp.float32)
    vals = lat.astype(jnp.float32)
    qi = qi.reshape(B, S, IDX_HEADS, IDX_DIM).astype(jnp.float32)
    ki = ki.astype(jnp.float32)
    wi = wi.astype(jnp.float32) * (IDX_HEADS ** -0.5)
    bidx = jnp.arange(B)[:, None, None]
    key_pos = jnp.arange(S)
    scale = DSA_LATENT ** -0.5

    def block(args):
        qb, qib, wib, t0 = args
        t = t0 + jnp.arange(Q_BLOCK)
        isc = jax.nn.relu(jnp.einsum('bqhd,bsd->bqhs', qib, ki))
        isc = jnp.einsum('bqhs,bqh->bqs', isc, wib)
        causal = key_pos[None, :] <= t[:, None]
        isc = jnp.where(causal[None], isc, NEG)
        _, sel = lax.top_k(isc, topk)
        valid = sel <= t[None, :, None]
        kg = k[bidx, sel]
        vg = vals[bidx, sel]
        logits = jnp.einsum('bqhd,bqkd->bqhk', qb, kg) * scale
        bias = rel_bias[t5_bucket(t[None, :, None] - sel)]
        logits = logits + jnp.swapaxes(bias, -1, -2).astype(jnp.float32)
        logits = jnp.where(valid[:, :, None, :], logits, NEG)
        p = jax.nn.softmax(logits, axis=-1)
        return jnp.einsum('bqhk,bqkd->bqhd', p, vg)

    starts = jnp.arange(S // Q_BLOCK) * Q_BLOCK
    o_lat = _unblocks(lax.map(block, (_blocks(q), _blocks(qi), _blocks(wi), starts)))
    o = jnp.einsum('bshl,hlv->bshv', o_lat, w_uv.astype(jnp.float32))
    return o.reshape(B, S, DSA_HEADS * DSA_V_DIM).astype(h.dtype) @ w_out


def conv_ffn(h, w_up, conv_w, conv_b, w_down):
    S = h.shape[1]
    u = h @ w_up
    up = jnp.pad(u, ((0, 0), (CONV_W - 1, 0), (0, 0)))
    y = conv_b
    for j in range(CONV_W):
        y = y + up[:, j:j + S] * conv_w[j]
    gate, val = jnp.split(y, 2, axis=-1)
    return (jax.nn.silu(gate) * val) @ w_down


def setup_inputs(seed: int = 0) -> dict:
    key = jax.random.key(seed)
    ks = jax.random.split(key, 20)
    f32 = jnp.float32
    D = D_MODEL

    def nrm(k, shape, s):
        return jax.random.normal(k, shape, f32) * s

    return {
        'x': nrm(ks[0], (BATCH, SEQ, D), 1.0),
        'c': nrm(ks[1], (BATCH, D), 1.0),
        'ada_w': nrm(ks[2], (DEPTH, D, 6 * D), 0.5 * D ** -0.5),
        'ada_b': nrm(ks[3], (DEPTH, 6 * D), 0.01),
        'norm_mix': 1.0 + nrm(ks[4], (DEPTH, D), 0.05),
        'norm_ffn': 1.0 + nrm(ks[5], (DEPTH, D), 0.05),
        'sb_w_in': nrm(ks[6], (N_A_LAYERS, D, 3 * SB_HEADS * SB_HEAD_DIM), D ** -0.5),
        'sb_w_out': nrm(ks[7], (N_A_LAYERS, SB_HEADS * SB_HEAD_DIM, D), (SB_HEADS * SB_HEAD_DIM) ** -0.5),
        'dsa_w_in': nrm(ks[8], (N_B_LAYERS, D, DSA_IN), D ** -0.5),
        'dsa_q_norm': 1.0 + nrm(ks[9], (N_B_LAYERS, DSA_LATENT), 0.05),
        'dsa_k_norm': 1.0 + nrm(ks[10], (N_B_LAYERS, DSA_LATENT), 0.05),
        'dsa_w_uv': nrm(ks[11], (N_B_LAYERS, DSA_HEADS, DSA_LATENT, DSA_V_DIM), DSA_LATENT ** -0.5),
        'dsa_w_out': nrm(ks[12], (N_B_LAYERS, DSA_HEADS * DSA_V_DIM, D), (DSA_HEADS * DSA_V_DIM) ** -0.5),
        'rel_bias': nrm(ks[13], (NUM_BUCKETS, DSA_HEADS), 0.5),
        'ffn_w_up': nrm(ks[14], (DEPTH, D, 2 * FFN_DIM), D ** -0.5),
        'ffn_conv_w': nrm(ks[15], (DEPTH, CONV_W, 2 * FFN_DIM), CONV_W ** -0.5),
        'ffn_conv_b': nrm(ks[16], (DEPTH, 2 * FFN_DIM), 0.01),
        'ffn_w_down': nrm(ks[17], (DEPTH, FFN_DIM, D), FFN_DIM ** -0.5),
    }


def reference(x, c, ada_w, ada_b, norm_mix, norm_ffn, sb_w_in, sb_w_out, dsa_w_in,
              dsa_q_norm, dsa_k_norm, dsa_w_uv, dsa_w_out, rel_bias, ffn_w_up,
              ffn_conv_w, ffn_conv_b, ffn_w_down):
    cond = jax.nn.silu(c)
    for i in range(DEPTH):
        mod = cond @ ada_w[i] + ada_b[i]
        sh1, sc1, g1, sh2, sc2, g2 = [m[:, None, :] for m in jnp.split(mod, 6, axis=-1)]
        h = rms_norm(x, norm_mix[i]) * (1.0 + sc1) + sh1
        j = i // N_MIXERS
        if i % N_MIXERS == 0:
            mix = stick_breaking_attention(h, sb_w_in[j], sb_w_out[j])
        else:
            mix = dsa_attention(h, dsa_w_in[j], dsa_q_norm[j], dsa_k_norm[j],
                                dsa_w_uv[j], dsa_w_out[j], rel_bias)
        x = x + g1 * mix
        h = rms_norm(x, norm_ffn[i]) * (1.0 + sc2) + sh2
        x = x + g2 * conv_ffn(h, ffn_w_up[i], ffn_conv_w[i], ffn_conv_b[i], ffn_w_down[i])
    return x
```

```cpp
#include <hip/hip_runtime.h>
#include <hip/hip_cooperative_groups.h>
#include <cstdio>
#include <cstdint>
namespace cg = cooperative_groups;

__device__ __forceinline__ int fresh_tid() { int t = threadIdx.x; asm volatile("" : "+v"(t)); return t; }
namespace pg8 {
#define PG8_LAS __attribute__((address_space(3)))
typedef unsigned short bf16_t;
typedef short bf16x8 __attribute__((ext_vector_type(8)));
typedef float f32x4 __attribute__((ext_vector_type(4)));
typedef unsigned u32x4 __attribute__((ext_vector_type(4)));
constexpr int BM = 256, BK = 64, HALF = 128, HTB = HALF * BK * 2  , STAGE_BYTES = 8 * HTB, NXCD = 8, WGM = 8;

__host__ __device__ __forceinline__ int lds_byte(int r, int c) { const int st = (r >> 4) * 2 + (c >> 5), rr = r & 15, cc = c & 31, ob = rr * 64 + cc * 2; return st * 1024 + (ob ^ (((ob >> 9) & 1) << 5)); }
__host__ __device__ __forceinline__ void stage_rc(int b, int& R, int& C) { const int st = b / 1024, sb = b % 1024, swz = sb ^ (((sb >> 9) & 1) << 5); R = (st >> 1) * 16 + swz / 64; C = (st & 1) * 32 + (swz % 64) / 2; }
__host__ __device__ __forceinline__ int perm32(int rho) { const int n = rho >> 4, i = rho & 15; return 8 * (i >> 2) + 4 * n + (i & 3); }

struct Unit { int pm, pn; };
struct Gemm { const bf16_t* A; const bf16_t* Bt; int M, N, K; };

struct StaticOrder {
    int nM, nN, nwg, G, c;
    __host__ __device__ void init(int M, int N, int G_, int c_) { nM = M / BM; nN = N / BM; nwg = nM * nN; G = G_; c = c_; }
    __host__ __device__ bool next(int i, Unit& u) const {
        const long L = (long)i * G + c; if (L >= nwg) return false;
        int wgid = (int)L; { const int q = nwg / NXCD, r = nwg % NXCD, xcd = wgid % NXCD, off = wgid / NXCD; wgid = (xcd < r ? xcd * (q + 1) : r * (q + 1) + (xcd - r) * q) + off; }
        const int nig = WGM * nN, gid = wgid / nig, fm = gid * WGM, gsz = (nM - fm) < WGM ? (nM - fm) : WGM;
        u.pm = fm + ((wgid % nig) % gsz); u.pn = (wgid % nig) / gsz; return true;
    }
    __device__ __forceinline__ void a_ready(const Unit&) const {}
    __device__ __forceinline__ void done(const Unit&) const {}
};

__device__ __forceinline__ unsigned cvt_pk_bf16(float lo, float hi) { unsigned r; asm volatile("v_cvt_pk_bf16_f32 %0, %1, %2" : "=v"(r) : "v"(lo), "v"(hi)); return r; }
template <class Epi, class Sched, bool ALIGN_EPI = false, bool SP2 = false>
__device__ __forceinline__ void gemm_phase(PG8_LAS unsigned char* lds, const Gemm g, const Sched& S, const Epi& E) {
    const int tid = fresh_tid(), wid = __builtin_amdgcn_readfirstlane(tid >> 6), lane = tid & 63, wr = wid >> 2, wc = wid & 3, fr = lane & 15, fq = lane >> 4;
    const int K = g.K, nt = K / BK;
    unsigned voffA[2], voffB[2];
#pragma unroll
    for (int i = 0; i < 2; ++i) { int R, C; stage_rc(tid * 16 + i * 8192, R, C); const int Rb = Epi::PERM ? ((R & ~31) + perm32(R & 31)) : R;
        voffA[i] = (unsigned)(R * K + C) * 2u; voffB[i] = (unsigned)(Rb * K + C) * 2u; }
    const size_t kstep = (size_t)(BK * 2);
    const size_t hstep = (size_t)HALF * K * 2;
    const size_t tstep = 2 * hstep;
    const unsigned ldsw = (unsigned)wid * 1024u;
    const int aoff = lds_byte(wr * 64 + fr, fq * 8), boff = lds_byte(wc * 32 + fr, fq * 8);
#define PG8_SA(b, h) (((b) * 2 + (h)) * HTB)
#define PG8_SB(b, h) ((4 + (b) * 2 + (h)) * HTB)
#define PG8_STAGE(bufoff, gbase, voff) do { _Pragma("unroll") for (int _i = 0; _i < 2; ++_i) \
        __builtin_amdgcn_global_load_lds((const unsigned*)((const char*)(gbase) + (voff)[_i]), (PG8_LAS unsigned*)(lds + (bufoff) + ldsw + _i * 8192), 16, 0, 0); } while (0)
#define PG8_LDA(dst, b, h) do { _Pragma("unroll") for (int m = 0; m < 4; ++m) _Pragma("unroll") for (int k = 0; k < 2; ++k) dst[m][k] = *(const PG8_LAS bf16x8*)(lds + PG8_SA(b, h) + aoff + m * 2048 + k * 1024); } while (0)
#define PG8_LDB(dst, b, h) do { _Pragma("unroll") for (int n = 0; n < 2; ++n) _Pragma("unroll") for (int k = 0; k < 2; ++k) dst[n][k] = *(const PG8_LAS bf16x8*)(lds + PG8_SB(b, h) + boff + n * 2048 + k * 1024); } while (0)
#define PG8_MMA(ai, bj, At, Bt) do { __builtin_amdgcn_s_setprio(1); _Pragma("unroll") for (int m = 0; m < 4; ++m) _Pragma("unroll") for (int n = 0; n < 2; ++n) _Pragma("unroll") for (int k = 0; k < 2; ++k) \
        acc[ai][bj][m][n] = __builtin_amdgcn_mfma_f32_16x16x32_bf16(Bt[n][k], At[m][k], acc[ai][bj][m][n], 0, 0, 0); __builtin_amdgcn_s_setprio(0); } while (0)
#define PG8_WAIT_V(n) asm volatile("s_waitcnt vmcnt(" #n ")" ::: "memory")
#define PG8_WAIT_L(n) asm volatile("s_waitcnt lgkmcnt(" #n ")" ::: "memory")
#define PG8_BAR __builtin_amdgcn_s_barrier()
#define PG8_SCHED __builtin_amdgcn_sched_barrier(0)
    Unit cur, nxt; int ui = 0;
    if (!S.next(0, cur)) return;
    f32x4 acc[2][2][4][2];
#pragma unroll
    for (int a = 0; a < 2; ++a)
#pragma unroll
        for (int b = 0; b < 2; ++b)
#pragma unroll
            for (int m = 0; m < 4; ++m)
#pragma unroll
                for (int n = 0; n < 2; ++n) acc[a][b][m][n] = (f32x4){0.f, 0.f, 0.f, 0.f};
    bf16x8 At[4][2], B0[2][2], B1[2][2];
    const char* cA = (const char*)g.A + (size_t)cur.pm * tstep; const char* cB = (const char*)g.Bt + (size_t)cur.pn * tstep;
    S.a_ready(cur);
    if constexpr (SP2) {
        PG8_STAGE(PG8_SB(0, 0), cB, voffB); PG8_STAGE(PG8_SB(0, 1), cB + hstep, voffB); PG8_STAGE(PG8_SA(0, 0), cA, voffA); PG8_STAGE(PG8_SA(0, 1), cA + hstep, voffA);
        if (wr == 1) PG8_BAR;
        PG8_WAIT_V(2); PG8_BAR;
        PG8_STAGE(PG8_SB(1, 0), cB + kstep, voffB); PG8_STAGE(PG8_SA(1, 0), cA + kstep, voffA); PG8_STAGE(PG8_SB(1, 1), cB + hstep + kstep, voffB);
        PG8_WAIT_V(6); PG8_BAR;
    } else {
        PG8_STAGE(PG8_SB(0, 0), cB, voffB); PG8_STAGE(PG8_SA(0, 0), cA, voffA); PG8_STAGE(PG8_SB(0, 1), cB + hstep, voffB); PG8_STAGE(PG8_SA(0, 1), cA + hstep, voffA);
        if (wr == 1) PG8_BAR;
        PG8_WAIT_V(4); PG8_BAR;
        PG8_STAGE(PG8_SB(1, 0), cB + kstep, voffB); PG8_STAGE(PG8_SA(1, 0), cA + kstep, voffA); PG8_STAGE(PG8_SB(1, 1), cB + hstep + kstep, voffB);
        PG8_WAIT_V(6); PG8_BAR;
    }
    for (;;) {
        const bool has_next = S.next(ui + 1, nxt);
        const char* nA = has_next ? (const char*)g.A + (size_t)nxt.pm * tstep : cA; const char* nB = has_next ? (const char*)g.Bt + (size_t)nxt.pn * tstep : cB;
        for (int t = 0; t < nt; t += 2) {
            const bool last = (t == nt - 2);
            const char* a1 = cA + (size_t)(t + 1) * kstep;
            const char* a2 = last ? nA : cA + (size_t)(t + 2) * kstep; const char* b2 = last ? nB : cB + (size_t)(t + 2) * kstep;
            const char* a3 = a2 + kstep; const char* b3 = b2 + kstep;
            if (last && has_next) S.a_ready(nxt);
            if constexpr (SP2) {
            PG8_LDB(B0, 0, 0); PG8_LDB(B1, 0, 1); PG8_SCHED; PG8_LDA(At, 0, 0); PG8_STAGE(PG8_SA(1, 1), a1 + hstep, voffA);
            PG8_WAIT_V(8); PG8_WAIT_L(0); PG8_BAR; PG8_MMA(0, 0, At, B0); PG8_MMA(0, 1, At, B1); PG8_BAR; PG8_SCHED;
            PG8_LDA(At, 0, 1); PG8_STAGE(PG8_SB(0, 0), b2, voffB); PG8_STAGE(PG8_SB(0, 1), b2 + hstep, voffB); PG8_STAGE(PG8_SA(0, 0), a2, voffA);
            PG8_WAIT_V(8); PG8_WAIT_L(0); PG8_BAR; PG8_MMA(1, 0, At, B0); PG8_MMA(1, 1, At, B1); PG8_BAR; PG8_SCHED;
            PG8_LDB(B0, 1, 0); PG8_LDB(B1, 1, 1); PG8_SCHED; PG8_LDA(At, 1, 0); PG8_STAGE(PG8_SA(0, 1), a2 + hstep, voffA);
            PG8_WAIT_V(8); PG8_WAIT_L(0); PG8_BAR; PG8_MMA(0, 0, At, B0); PG8_MMA(0, 1, At, B1); PG8_BAR; PG8_SCHED;
            PG8_LDA(At, 1, 1); PG8_STAGE(PG8_SB(1, 0), b3, voffB); PG8_STAGE(PG8_SB(1, 1), b3 + hstep, voffB); PG8_STAGE(PG8_SA(1, 0), a3, voffA);
            PG8_WAIT_V(8); PG8_WAIT_L(0); PG8_BAR; PG8_MMA(1, 0, At, B0); PG8_MMA(1, 1, At, B1); PG8_BAR; PG8_SCHED;
            } else {
            PG8_LDB(B0, 0, 0); PG8_SCHED; PG8_LDA(At, 0, 0); PG8_STAGE(PG8_SA(1, 1), a1 + hstep, voffA);
            PG8_WAIT_L(8); PG8_BAR; PG8_WAIT_L(0); PG8_MMA(0, 0, At, B0); PG8_BAR; PG8_SCHED;
            PG8_LDB(B1, 0, 1); PG8_STAGE(PG8_SB(0, 0), b2, voffB);
            PG8_BAR; PG8_WAIT_L(0); PG8_MMA(0, 1, At, B1); PG8_BAR;
            PG8_LDA(At, 0, 1); PG8_STAGE(PG8_SA(0, 0), a2, voffA);
            PG8_BAR; PG8_WAIT_L(0); PG8_MMA(1, 0, At, B0); PG8_BAR; PG8_SCHED;
            PG8_STAGE(PG8_SB(0, 1), b2 + hstep, voffB);
            PG8_WAIT_V(6); PG8_BAR; PG8_MMA(1, 1, At, B1); PG8_BAR;
            PG8_LDB(B0, 1, 0); PG8_SCHED; PG8_LDA(At, 1, 0); PG8_STAGE(PG8_SA(0, 1), a2 + hstep, voffA);
            PG8_WAIT_L(8); PG8_BAR; PG8_WAIT_L(0); PG8_MMA(0, 0, At, B0); PG8_BAR; PG8_SCHED;
            PG8_LDB(B1, 1, 1); PG8_STAGE(PG8_SB(1, 0), b3, voffB);
            PG8_BAR; PG8_WAIT_L(0); PG8_MMA(0, 1, At, B1); PG8_BAR;
            PG8_LDA(At, 1, 1); PG8_STAGE(PG8_SA(1, 0), a3, voffA);
            PG8_BAR; PG8_WAIT_L(0); PG8_MMA(1, 0, At, B0); PG8_BAR; PG8_SCHED;
            PG8_STAGE(PG8_SB(1, 1), b3 + hstep, voffB);
            PG8_WAIT_V(6); PG8_BAR; PG8_MMA(1, 1, At, B1); PG8_BAR;
            }
        }
        if constexpr (ALIGN_EPI) { if (wr == 0) PG8_BAR; }
        if constexpr (!Epi::AFTER_DRAIN) { E(acc, cur, wr, wc, fr, fq); S.done(cur); }
        if (!has_next) break;
#pragma unroll
        for (int a = 0; a < 2; ++a)
#pragma unroll
            for (int b = 0; b < 2; ++b)
#pragma unroll
                for (int m = 0; m < 4; ++m)
#pragma unroll
                    for (int n = 0; n < 2; ++n) acc[a][b][m][n] = (f32x4){0.f, 0.f, 0.f, 0.f};
        cur = nxt; cA = nA; cB = nB; ++ui;
        if constexpr (ALIGN_EPI) { if (wr == 1) PG8_BAR; }
    }
    PG8_WAIT_V(0);
    if constexpr (!ALIGN_EPI) { if (wr == 0) PG8_BAR; }
    PG8_BAR;
    if constexpr (Epi::AFTER_DRAIN) { E.fused(acc, cur, wr, wc, fr, fq, lds, wid, lane); S.done(cur); }
#undef PG8_SA
#undef PG8_SB
#undef PG8_STAGE
#undef PG8_LDA
#undef PG8_LDB
#undef PG8_MMA
#undef PG8_WAIT_V
#undef PG8_WAIT_L
#undef PG8_BAR
#undef PG8_SCHED
}
}

#define LAS __attribute__((address_space(3)))
typedef unsigned short bf16_t;
typedef short bf16x8 __attribute__((ext_vector_type(8)));
typedef short s16x4 __attribute__((ext_vector_type(4)));
typedef float f32x4 __attribute__((ext_vector_type(4)));
typedef float f32x16 __attribute__((ext_vector_type(16)));
typedef unsigned u32x4 __attribute__((ext_vector_type(4)));
typedef unsigned u32x2 __attribute__((ext_vector_type(2)));

constexpr int DM = 1024, NBATCH = 8, SEQ = 4096, TOK = NBATCH * SEQ, FFN = 2816, FFN2 = 5632;
constexpr int DSA_N = 2760, PROJ_LD = 2816;
constexpr int PJ_LAT = 2048, PJ_QI = 2176, PJ_KI = 2688, PJ_WI = 2752;
constexpr float RMS_EPS = 1e-6f, LOG2E = 1.4426950408889634f;
constexpr int NTHR = 512, NWAVE = 8;
constexpr int LDS_PHASE_BYTES = 156160, LDS_BYTES = LDS_PHASE_BYTES + 64;

constexpr size_t MiB = 1u << 20;
constexpr size_t WS_MOD = 0;
constexpr size_t WS_BIASD = 512 * 1024;
constexpr size_t WS_RK = 1 * MiB;
constexpr size_t WS_BAR = 1536 * 1024;
constexpr size_t WS_WQKV = 2 * MiB;
constexpr size_t WS_WSBO = 8 * MiB;
constexpr size_t WS_WDIN = 10 * MiB;
constexpr size_t WS_WDO = 16 * MiB;
constexpr size_t WS_WUP0 = 20 * MiB, WS_WUP1 = 31 * MiB;
constexpr size_t WS_WDN0 = 42 * MiB, WS_WDN1 = 48 * MiB;
constexpr size_t WS_HF = 54 * MiB, WS_HL = 76 * MiB;
constexpr size_t WS_H = 100 * MiB;
constexpr size_t WS_A = 164 * MiB;
constexpr size_t WS_B = 356 * MiB;
constexpr size_t WS_SEL = 484 * MiB;
constexpr size_t WS_END = 500 * MiB;

struct Params { const float* in[18]; float* out; unsigned char* ws; };

__device__ __forceinline__ unsigned f2bf(float f) { unsigned u = __builtin_bit_cast(unsigned, f); return (u + 0x7fffu + ((u >> 16) & 1u)) >> 16; }
__device__ __forceinline__ unsigned pk2(float lo, float hi) { return f2bf(lo) | (f2bf(hi) << 16); }
__device__ __forceinline__ float bflo(unsigned w) { return __builtin_bit_cast(float, w << 16); }
__device__ __forceinline__ float bfhi(unsigned w) { return __builtin_bit_cast(float, w & 0xffff0000u); }
__device__ __forceinline__ float wave_sum(float v) {
#pragma unroll
    for (int o = 1; o < 64; o <<= 1) v += __shfl_xor(v, o);
    return v;
}
#define LDS_WAIT() asm volatile("s_waitcnt lgkmcnt(0)" ::: "memory")

struct EpiBf16 {
    static constexpr bool PERM = true, AFTER_DRAIN = false;
    bf16_t* O; int ldc; int split_cols; size_t split_stride; float scale0;
    __device__ __forceinline__ void operator()(const f32x4 (&acc)[2][2][4][2], const pg8::Unit& u, int wr, int wc, int fr, int fq) const {
        const int row0 = u.pm * 256 + wr * 64 + fr; int colt = u.pn * 256; bf16_t* base = O;
        float sc = 1.f; if (split_cols) { const int t = colt / split_cols; base += (size_t)t * split_stride; colt -= t * split_cols; if (t == 0) sc = scale0; }
        const int col0 = colt + wc * 32 + 8 * fq;
#pragma unroll
        for (int ai = 0; ai < 2; ++ai)
#pragma unroll
            for (int m = 0; m < 4; ++m) { bf16_t* rowp = base + (size_t)(row0 + ai * 128 + m * 16) * ldc + col0;
#pragma unroll
                for (int bj = 0; bj < 2; ++bj) { const f32x4 v0 = acc[ai][bj][m][0] * sc, v1 = acc[ai][bj][m][1] * sc;
                    u32x4 w; w.x = pg8::cvt_pk_bf16(v0[0], v0[1]); w.y = pg8::cvt_pk_bf16(v0[2], v0[3]); w.z = pg8::cvt_pk_bf16(v1[0], v1[1]); w.w = pg8::cvt_pk_bf16(v1[2], v1[3]);
                    *(u32x4*)(rowp + bj * 128) = w; } }
    }
};
template <int CTRL> __device__ __forceinline__ float dpp_ror(float v) { return __builtin_bit_cast(float, __builtin_amdgcn_update_dpp(0, __builtin_bit_cast(int, v), CTRL, 0xf, 0xf, false)); }
struct EpiResid {
    static constexpr bool PERM = false, AFTER_DRAIN = false;
    const float* resid; float* out; const float* gate;
    __device__ __forceinline__ void operator()(const f32x4 (&acc)[2][2][4][2], const pg8::Unit& u, int wr, int wc, int fr, int fq) const {
        const float* g = gate + (size_t)(u.pm >> 4) * 6144;
        const int col0 = u.pn * 256 + wc * 32 + 4 * fq;
        f32x4 gv[2][2];
#pragma unroll
        for (int bj = 0; bj < 2; ++bj)
#pragma unroll
            for (int n = 0; n < 2; ++n) gv[bj][n] = *(const f32x4*)(g + col0 + bj * 128 + n * 16);
        const bool lo8 = fr < 8;
        const int rsel = fr & 7, csel = lo8 ? 0 : 16;
#pragma unroll
        for (int ai = 0; ai < 2; ++ai)
#pragma unroll
            for (int m = 0; m < 4; ++m) { const size_t off = (size_t)(u.pm * 256 + ai * 128 + wr * 64 + m * 16 + fr) * DM + col0;
                const size_t offs = (size_t)(u.pm * 256 + ai * 128 + wr * 64 + m * 16 + rsel) * DM + col0 + csel;
#pragma unroll
                for (int bj = 0; bj < 2; ++bj) {
                    const f32x4 a = *(const f32x4*)(resid + off + bj * 128) + gv[bj][0] * acc[ai][bj][m][0];
                    const f32x4 b = *(const f32x4*)(resid + off + bj * 128 + 16) + gv[bj][1] * acc[ai][bj][m][1];
                    f32x4 y;
#pragma unroll
                    for (int j = 0; j < 4; ++j) y[j] = dpp_ror<0x128>(lo8 ? b[j] : a[j]);
                    f32x4 s1, s2;
#pragma unroll
                    for (int j = 0; j < 4; ++j) { s1[j] = lo8 ? a[j] : y[j]; s2[j] = lo8 ? y[j] : b[j]; }
                    *(f32x4*)(out + offs + bj * 128) = s1;
                    *(f32x4*)(out + offs + (size_t)8 * DM + bj * 128) = s2;
                }
            }
    }
};
__device__ __forceinline__ float silu_f(float g) { return g * __builtin_amdgcn_rcpf(1.f + __builtin_amdgcn_exp2f(-g * LOG2E)); }
struct EpiConvGate {
    static constexpr bool PERM = true, AFTER_DRAIN = false;
    bf16_t* act; float* hf; float* hl; const float* cw; const float* cb;
    __device__ __forceinline__ void operator()(const f32x4 (&acc)[2][2][4][2], const pg8::Unit& u, int wr, int wc, int fr, int fq) const {
#pragma unroll
        for (int n = 0; n < 2; ++n) {
            const int f0 = u.pn * 128 + wc * 32 + 8 * fq + 4 * n;
            f32x4 w[2][3], bb[2];
#pragma unroll
            for (int bj = 0; bj < 2; ++bj) { const int col = bj * FFN + f0; bb[bj] = *(const f32x4*)(cb + col);
#pragma unroll
                for (int tp = 0; tp < 3; ++tp) w[bj][tp] = *(const f32x4*)(cw + tp * FFN2 + col); }
#pragma unroll
            for (int ai = 0; ai < 2; ++ai) {
                const int wb = (u.pm * 2 + ai) * 2 + wr;
                f32x4 p1[2], p2[2];
                p1[0] = p1[1] = p2[0] = p2[1] = (f32x4){0.f, 0.f, 0.f, 0.f};
#pragma unroll
                for (int m = 0; m < 4; ++m) {
                    f32x4 y[2];
#pragma unroll
                    for (int bj = 0; bj < 2; ++bj) {
                        const f32x4 cur = acc[ai][bj][m][n]; f32x4 r1, r2;
#pragma unroll
                        for (int j = 0; j < 4; ++j) { r1[j] = dpp_ror<0x121>(cur[j]); r2[j] = dpp_ror<0x122>(cur[j]); }
                        const f32x4 s1 = (fr >= 1) ? r1 : p1[bj], s2 = (fr >= 2) ? r2 : p2[bj];
                        y[bj] = bb[bj] + w[bj][0] * s2 + w[bj][1] * s1 + w[bj][2] * cur;
                        p1[bj] = r1; p2[bj] = r2;
                        if (m == 0 && fr < 2) *(f32x4*)(hf + (size_t)(wb * 2 + fr) * FFN2 + bj * FFN + f0) = cur;
                        if (m == 3 && fr >= 14) *(f32x4*)(hl + (size_t)(wb * 2 + fr - 14) * FFN2 + bj * FFN + f0) = cur;
                    }
                    u32x2 o; o.x = pg8::cvt_pk_bf16(silu_f(y[0][0]) * y[1][0], silu_f(y[0][1]) * y[1][1]); o.y = pg8::cvt_pk_bf16(silu_f(y[0][2]) * y[1][2], silu_f(y[0][3]) * y[1][3]);
                    *(u32x2*)(act + (size_t)(wb * 64 + m * 16 + fr) * FFN + f0) = o;
                }
            }
        }
    }
};

__device__ __forceinline__ void transpose_item(const float* W, int K, int N, bf16_t* WT, int dst_row0, LAS float* scr, int k0, int n0, int lane) {
    const int c4 = (lane & 7) * 4, n = n0 + c4;
#pragma unroll
    for (int i = 0; i < 8; ++i) { const int kk = 8 * i + (lane >> 3);
        const f32x4 v = (n < N) ? *(const f32x4*)(W + (size_t)(k0 + kk) * N + n) : (f32x4){0.f, 0.f, 0.f, 0.f};
        scr[kk * 33 + c4] = v[0]; scr[kk * 33 + c4 + 1] = v[1]; scr[kk * 33 + c4 + 2] = v[2]; scr[kk * 33 + c4 + 3] = v[3]; }
    LDS_WAIT();
    const int c = lane & 7;
#pragma unroll
    for (int j = 0; j < 4; ++j) { const int nn = (lane >> 3) + 8 * j; const LAS float* s = scr + (8 * c) * 33 + nn;
        u32x4 o; o.x = pk2(s[0 * 33], s[1 * 33]); o.y = pk2(s[2 * 33], s[3 * 33]); o.z = pk2(s[4 * 33], s[5 * 33]); o.w = pk2(s[6 * 33], s[7 * 33]);
        *(u32x4*)(WT + (size_t)(dst_row0 + nn) * K + k0 + 8 * c) = o; }
    LDS_WAIT();
}
__device__ __forceinline__ int t5_bucket(int n) {
    if (n < 16) return n;
    return 16 + (n >= 19) + (n >= 21) + (n >= 24) + (n >= 27) + (n >= 31) + (n >= 35) + (n >= 40) + (n >= 46) + (n >= 52) + (n >= 59) + (n >= 67) + (n >= 77) + (n >= 87) + (n >= 99) + (n >= 113);
}
__device__ __forceinline__ void p0_prologue(const Params& p, LAS unsigned char* lds) {
    const int tid = fresh_tid(), lane = tid & 63, wave = tid >> 6, G = gridDim.x;
    const int gw = blockIdx.x * NWAVE + wave, NGW = G * NWAVE;
    unsigned char* ws = p.ws;
    {
        LAS float* condS = (LAS float*)lds;
        LAS float* red = (LAS float*)(lds + 32768);
        if ((int)blockIdx.x < 192) {
            for (int e = tid; e < NBATCH * DM; e += NTHR) { const float c = p.in[1][e]; condS[e] = c / (1.f + __expf(-c)); }
            __syncthreads();
        }
        for (int item = blockIdx.x; item < 192; item += G) {
            const int l = item / 96, col0 = (item % 96) * 64, col = tid & 63, kg = tid >> 6;
            const float* W = p.in[2] + (size_t)l * DM * 6144 + col0 + col;
            float a[8];
#pragma unroll
            for (int b = 0; b < 8; ++b) a[b] = 0.f;
#pragma unroll 8
            for (int k = kg * 128; k < kg * 128 + 128; ++k) { const float w = W[(size_t)k * 6144];
#pragma unroll
                for (int b = 0; b < 8; ++b) a[b] += condS[b * DM + k] * w; }
#pragma unroll
            for (int b = 0; b < 8; ++b) red[(kg * 8 + b) * 64 + col] = a[b];
            __syncthreads();
            { const int b = tid >> 6; float s = 0.f;
#pragma unroll
              for (int g = 0; g < 8; ++g) s += red[(g * 8 + b) * 64 + col];
              ((float*)(ws + WS_MOD))[(size_t)(l * 8 + b) * 6144 + col0 + col] = s + p.in[3][l * 6144 + col0 + col]; }
            __syncthreads();
        }
        __syncthreads();
    }
    { const int g = blockIdx.x * NTHR + tid; if (g < 2048) ((float*)(ws + WS_BIASD))[g] = p.in[13][t5_bucket(g >> 4) * 16 + (g & 15)] * LOG2E; }
}
__device__ __forceinline__ void p0_weights(const Params& p, LAS unsigned char* lds) {
    const int tid = fresh_tid(), lane = tid & 63, wave = tid >> 6, G = gridDim.x;
    const int gw = blockIdx.x * NWAVE + wave, NGW = G * NWAVE;
    unsigned char* ws = p.ws;
    {
        LAS float* scr = (LAS float*)(lds + wave * 16384);
        for (int it = gw; it < 11904; it += NGW) {
            const float* W; int K, N, nblk, mode = 0, r = it; bf16_t* WT;
            if (r < 1536) { W = p.in[6]; K = 1024; N = 3072; nblk = 96; WT = (bf16_t*)(ws + WS_WQKV); }
            else if ((r -= 1536) < 512) { W = p.in[7]; K = 1024; N = 1024; nblk = 32; WT = (bf16_t*)(ws + WS_WSBO); }
            else if ((r -= 512) < 1408) { W = p.in[8]; K = 1024; N = DSA_N; nblk = 88; WT = (bf16_t*)(ws + WS_WDIN); }
            else if ((r -= 1408) < 2816) { W = p.in[14]; K = 1024; N = FFN2; nblk = 176; WT = (bf16_t*)(ws + WS_WUP0); mode = 1; }
            else if ((r -= 2816) < 2816) { W = p.in[14] + (size_t)DM * FFN2; K = 1024; N = FFN2; nblk = 176; WT = (bf16_t*)(ws + WS_WUP1); mode = 1; }
            else if ((r -= 2816) < 1408) { W = p.in[17]; K = FFN; N = 1024; nblk = 32; WT = (bf16_t*)(ws + WS_WDN0); }
            else { r -= 1408; W = p.in[17] + (size_t)FFN * DM; K = FFN; N = 1024; nblk = 32; WT = (bf16_t*)(ws + WS_WDN1); }
            const int kb = r / nblk, nb = r % nblk, n0 = nb * 32;
            int dst = n0;
            if (mode == 1) { const int bj = n0 / FFN, f = n0 % FFN; dst = 256 * (f / 128) + 128 * bj + (f % 128); }
            transpose_item(W, K, N, WT, dst, scr, kb * 64, n0, lane);
        }
    }
    for (int it = gw; it < 4096; it += NGW) {
        const int n0 = (it >> 5) * 8, k = (it & 31) * 64 + lane, h = k >> 7;
        const float* uv = p.in[11] + (size_t)k * 64;
        const float* wo = p.in[12] + (size_t)(h * 64) * DM + n0;
        float a[8];
#pragma unroll
        for (int i = 0; i < 8; ++i) a[i] = 0.f;
#pragma unroll 4
        for (int v4 = 0; v4 < 16; ++v4) { const f32x4 x = *(const f32x4*)(uv + v4 * 4);
#pragma unroll
            for (int j = 0; j < 4; ++j) { const f32x4 w0 = *(const f32x4*)(wo + (size_t)(v4 * 4 + j) * DM), w1 = *(const f32x4*)(wo + (size_t)(v4 * 4 + j) * DM + 4);
                a[0] += x[j] * w0[0]; a[1] += x[j] * w0[1]; a[2] += x[j] * w0[2]; a[3] += x[j] * w0[3];
                a[4] += x[j] * w1[0]; a[5] += x[j] * w1[1]; a[6] += x[j] * w1[2]; a[7] += x[j] * w1[3]; } }
        bf16_t* WT = (bf16_t*)(ws + WS_WDO);
#pragma unroll
        for (int i = 0; i < 8; ++i) WT[(size_t)(n0 + i) * 2048 + k] = (bf16_t)f2bf(a[i]);
    }
}

__device__ __forceinline__ void norm_phase(const float* src, const float* gain, const float* mod_l, int sh_off, int sc_off, bf16_t* dst) {
    const int tid = fresh_tid(), lane = tid & 63, gw = blockIdx.x * NWAVE + (tid >> 6), NGW = gridDim.x * NWAVE;
    for (int row = gw; row < TOK; row += NGW) {
        const f32x4* xr = (const f32x4*)(src + (size_t)row * DM) + lane;
        f32x4 v[4]; float ss = 0.f;
#pragma unroll
        for (int j = 0; j < 4; ++j) { v[j] = xr[64 * j]; ss += (v[j].x * v[j].x + v[j].y * v[j].y) + (v[j].z * v[j].z + v[j].w * v[j].w); }
        const float r = rsqrtf(wave_sum(ss) * (1.f / DM) + RMS_EPS);
        const float* mb = mod_l + (size_t)(row >> 12) * 6144;
        u32x2* o8 = (u32x2*)(dst + (size_t)row * DM) + lane;
#pragma unroll
        for (int j = 0; j < 4; ++j) { const int col = 4 * lane + 256 * j;
            const f32x4 g = *(const f32x4*)(gain + col), sc = *(const f32x4*)(mb + sc_off + col), sh = *(const f32x4*)(mb + sh_off + col);
            const f32x4 y = v[j] * r * g * (sc + 1.f) + sh;
            u32x2 o; o.x = pk2(y[0], y[1]); o.y = pk2(y[2], y[3]); o8[64 * j] = o; }
    }
}

__device__ __forceinline__ void fixup_phase(const float* hf, const float* hl, const float* cw, const float* cb, bf16_t* act) {
    const int gt = blockIdx.x * NTHR + fresh_tid(), NT = gridDim.x * NTHR;
    const f32x4 zero4 = (f32x4){0.f, 0.f, 0.f, 0.f};
    for (int e = gt; e < 512 * 2 * (FFN / 4); e += NT) {
        const int f = 4 * (e % (FFN / 4)), j = (e / (FFN / 4)) & 1, wb = e / (2 * (FFN / 4));
        const bool first = (wb & 63) == 0;
        f32x4 y[2];
#pragma unroll
        for (int part = 0; part < 2; ++part) {
            const int col = part * FFN + f;
            const f32x4 u0 = *(const f32x4*)(hf + (size_t)(wb * 2 + j) * FFN2 + col);
            const f32x4 lm1 = first ? zero4 : *(const f32x4*)(hl + (size_t)((wb - 1) * 2 + 1) * FFN2 + col);
            const f32x4 lm2 = first ? zero4 : *(const f32x4*)(hl + (size_t)((wb - 1) * 2 + 0) * FFN2 + col);
            const f32x4 u1 = j ? *(const f32x4*)(hf + (size_t)(wb * 2) * FFN2 + col) : lm1;
            const f32x4 u2 = j ? lm1 : lm2;
            y[part] = *(const f32x4*)(cb + col) + *(const f32x4*)(cw + col) * u2 + *(const f32x4*)(cw + FFN2 + col) * u1 + *(const f32x4*)(cw + 2 * FFN2 + col) * u0;
        }
        u32x2 o; o.x = pk2(silu_f(y[0][0]) * y[1][0], silu_f(y[0][1]) * y[1][1]); o.y = pk2(silu_f(y[0][2]) * y[1][2], silu_f(y[0][3]) * y[1][3]);
        *(u32x2*)(act + (size_t)(wb * 64 + j) * FFN + f) = o;
    }
}

__device__ __forceinline__ int crow(int r, int hi) { return (r & 3) + 8 * (r >> 2) + 4 * hi; }
__device__ __forceinline__ float other_half(float x) { const unsigned u = __builtin_bit_cast(unsigned, x); auto rr = __builtin_amdgcn_permlane32_swap(u, u, false, false);
    return __builtin_bit_cast(float, (unsigned)(rr[0] ^ rr[1] ^ u)); }
__device__ __forceinline__ void sb_qk(const LAS unsigned char* tb, const bf16x8 (&qr)[4], f32x16& p0, f32x16& p1, unsigned krd) {
    constexpr int KPITCH = 144;
    p0 = f32x16{}; p1 = f32x16{};
#pragma unroll
    for (int d0 = 0; d0 < 4; ++d0) {
        const bf16x8 a0 = *(const LAS bf16x8*)(tb + krd + d0 * 32);
        const bf16x8 a1 = *(const LAS bf16x8*)(tb + krd + 32 * KPITCH + d0 * 32);
        p0 = __builtin_amdgcn_mfma_f32_32x32x16_bf16(a0, qr[d0], p0, 0, 0, 0);
        p1 = __builtin_amdgcn_mfma_f32_32x32x16_bf16(a1, qr[d0], p1, 0, 0, 0);
    }
}
template <bool BAND> __device__ __forceinline__ void sb_sigma(f32x16& p0, f32x16& p1, int j, int t, int hi) {
#pragma unroll
    for (int r = 0; r < 16; ++r) {
        p0[r] = __builtin_amdgcn_rcpf(1.f + __builtin_amdgcn_exp2f(-p0[r]));
        p1[r] = __builtin_amdgcn_rcpf(1.f + __builtin_amdgcn_exp2f(-p1[r]));
    }
    if (BAND) {
#pragma unroll
        for (int r = 0; r < 16; ++r) { const int kv = 64 * j + crow(r, hi); if (kv >= t) p0[r] = 0.f; if (kv + 32 >= t) p1[r] = 0.f; }
    }
}
__device__ __forceinline__ void sb_local(f32x16& p, float (&G)[4]) {
#pragma unroll
    for (int g = 0; g < 4; ++g) {
        const float k0 = 1.f - p[4 * g], k1 = 1.f - p[4 * g + 1], k2 = 1.f - p[4 * g + 2], k3 = 1.f - p[4 * g + 3];
        const float s2 = k3, s1 = k3 * k2, s0 = s1 * k1;
        p[4 * g + 2] *= s2; p[4 * g + 1] *= s1; p[4 * g] *= s0; G[g] = s0 * k0;
    }
}
__device__ __forceinline__ void sb_chain(const float (&G1)[4], const float (&G0)[4], float& acc, float (&mine1)[4], float (&mine0)[4], int r32, int hi) {
#pragma unroll
    for (int g = 3; g >= 0; --g) {
        const float gl = __shfl(G1[g], r32), gh = __shfl(G1[g], r32 + 32);
        const float m1 = acc; acc *= gh; const float m0 = acc; acc *= gl; mine1[g] = hi ? m1 : m0;
    }
#pragma unroll
    for (int g = 3; g >= 0; --g) {
        const float gl = __shfl(G0[g], r32), gh = __shfl(G0[g], r32 + 32);
        const float m1 = acc; acc *= gh; const float m0 = acc; acc *= gl; mine0[g] = hi ? m1 : m0;
    }
}
__device__ __forceinline__ void sb_pv(const LAS unsigned char* tb, const f32x16& p0, const f32x16& p1, const float (&mine0)[4], const float (&mine1)[4], f32x16 (&o)[2], unsigned vrd) {
#pragma unroll
    for (int X = 1; X >= 0; --X)
#pragma unroll
        for (int s = 0; s < 2; ++s) {
            u32x4 pw;
#define AV(i) (X == 0 ? p0[8 * s + (i)] * mine0[(8 * s + (i)) >> 2] : p1[8 * s + (i)] * mine1[(8 * s + (i)) >> 2])
            pw.x = pg8::cvt_pk_bf16(AV(0), AV(1)); pw.y = pg8::cvt_pk_bf16(AV(2), AV(3)); pw.z = pg8::cvt_pk_bf16(AV(4), AV(5)); pw.w = pg8::cvt_pk_bf16(AV(6), AV(7));
#undef AV
            const bf16x8 pf = __builtin_bit_cast(bf16x8, pw);
#pragma unroll
            for (int c = 0; c < 2; ++c) {
                const LAS unsigned char* vp = tb + vrd + ((8 * X + 4 * s) * 4 + 2 * c) * 128;
                const s16x4 lo = __builtin_bit_cast(s16x4, __builtin_amdgcn_ds_read_tr16_b64_v4i16((LAS s16x4*)(vp)));
                const s16x4 hh = __builtin_bit_cast(s16x4, __builtin_amdgcn_ds_read_tr16_b64_v4i16((LAS s16x4*)(vp + 2 * 4 * 128)));
                const bf16x8 vf = (bf16x8){lo[0], lo[1], lo[2], lo[3], hh[0], hh[1], hh[2], hh[3]};
                o[c] = __builtin_amdgcn_mfma_f32_32x32x16_bf16(vf, pf, o[c], 0, 0, 0);
            }
        }
}
__device__ __forceinline__ void sb_tile(const LAS unsigned char* tb, int j, const bf16x8 (&qr)[4], f32x16 (&o)[2], float& Rp, int t, int tq0, int r32, int hi, unsigned krd, unsigned vrd) {
    if (!(64 * j < tq0 + 31)) return;
    if (__all(Rp == 0.f)) return;
    f32x16 p0, p1; float G0[4], G1[4], mine0[4], mine1[4];
    sb_qk(tb, qr, p0, p1, krd);
    if (64 * j + 63 >= tq0) sb_sigma<true>(p0, p1, j, t, hi); else sb_sigma<false>(p0, p1, j, t, hi);
    sb_local(p0, G0); sb_local(p1, G1);
    sb_chain(G1, G0, Rp, mine1, mine0, r32, hi);
    sb_pv(tb, p0, p1, mine0, mine1, o, vrd);
}
__device__ __forceinline__ void sb_tile2(const LAS unsigned char* tbA, const LAS unsigned char* tbB, const bf16x8 (&qr)[4], f32x16 (&o)[2], float& Rp, int r32, int hi, unsigned krd, unsigned vrd) {
    if (__all(Rp == 0.f)) return;
    f32x16 a0, a1, b0, b1; float GA0[4], GA1[4], GB0[4], GB1[4], mA0[4], mA1[4], mB0[4], mB1[4];
    sb_qk(tbA, qr, a0, a1, krd);
    sb_qk(tbB, qr, b0, b1, krd);
    sb_sigma<false>(a0, a1, 0, 0, hi);
    sb_local(a0, GA0); sb_local(a1, GA1);
    sb_chain(GA1, GA0, Rp, mA1, mA0, r32, hi);
    sb_sigma<false>(b0, b1, 0, 0, hi);
    sb_pv(tbA, a0, a1, mA0, mA1, o, vrd);
    sb_local(b0, GB0); sb_local(b1, GB1);
    sb_chain(GB1, GB0, Rp, mB1, mB0, r32, hi);
    sb_pv(tbB, b0, b1, mB0, mB1, o, vrd);
}
__device__ __forceinline__ void sb_attn_phase(const bf16_t* Q, const bf16_t* K, const bf16_t* V, bf16_t* O, LAS unsigned char* lds) {
    constexpr int KPITCH = 144, KBYTES = 64 * KPITCH, BUFB = KBYTES + 8192;
    const int tid = fresh_tid(), lane = tid & 63, r32 = lane & 31, hi = lane >> 5;
    const int wid = __builtin_amdgcn_readfirstlane(tid >> 6);
    const int kv_s = tid >> 3, d8 = tid & 7;
    const unsigned kst = kv_s * KPITCH + d8 * 16;
    const unsigned vst = KBYTES + ((kv_s >> 2) * 4 + (d8 >> 1)) * 128 + (kv_s & 3) * 32 + (d8 & 1) * 16;
    const unsigned vrd = KBYTES + (hi * 4 + ((lane >> 4) & 1)) * 128 + ((lane & 15) >> 2) * 32 + (lane & 3) * 8;
    const unsigned krd = r32 * KPITCH + hi * 16;
    LAS unsigned* votes = (LAS unsigned*)(lds + 4 * BUFB);
    for (int pi = blockIdx.x; pi < 1024; pi += gridDim.x) {
#pragma unroll 1
        for (int half = 0; half < 2; ++half) {
            const int bh = pi >> 3, sidx = pi & 7, qb = half ? 15 - sidx : sidx;
            const int b = bh >> 4, h = bh & 15;
            const size_t rowbase = (size_t)b * SEQ;
            const int q0 = qb * 256, tq0 = q0 + 32 * wid, t = tq0 + r32;
            const int NP = 2 * (qb + 1);
            bf16x8 qr[4];
#pragma unroll
            for (int d0 = 0; d0 < 4; ++d0) qr[d0] = *(const bf16x8*)(Q + (rowbase + t) * DM + h * 64 + d0 * 16 + hi * 8);
            f32x16 o[2]; o[0] = f32x16{}; o[1] = f32x16{};
            float Rp = 1.f;
            const bf16_t* Kg = K + (rowbase + kv_s) * DM + h * 64 + d8 * 8;
            const bf16_t* Vg = V + (rowbase + kv_s) * DM + h * 64 + d8 * 8;
            u32x4 kreg[2], vreg[2];
#pragma unroll
            for (int s = 0; s < 2; ++s) { kreg[s] = *(const u32x4*)(Kg + (size_t)(2 * (NP - 1) + s) * 64 * DM); vreg[s] = *(const u32x4*)(Vg + (size_t)(2 * (NP - 1) + s) * 64 * DM); }
#pragma unroll
            for (int s = 0; s < 2; ++s) { *(LAS u32x4*)(lds + s * BUFB + kst) = kreg[s]; *(LAS u32x4*)(lds + s * BUFB + vst) = vreg[s]; }
            __syncthreads();
            int cur = 0;
#pragma unroll 1
            for (int jp = NP - 1; jp >= 0; --jp) {
                if (jp > 0) {
#pragma unroll
                    for (int s = 0; s < 2; ++s) { kreg[s] = *(const u32x4*)(Kg + (size_t)(2 * (jp - 1) + s) * 64 * DM); vreg[s] = *(const u32x4*)(Vg + (size_t)(2 * (jp - 1) + s) * 64 * DM); }
                }
                const LAS unsigned char* tb = lds + cur * 2 * BUFB;
                if (64 * (2 * jp + 1) + 63 < tq0) sb_tile2(tb + BUFB, tb, qr, o, Rp, r32, hi, krd, vrd);
                else { sb_tile(tb + BUFB, 2 * jp + 1, qr, o, Rp, t, tq0, r32, hi, krd, vrd); sb_tile(tb, 2 * jp, qr, o, Rp, t, tq0, r32, hi, krd, vrd); }
                if (jp > 0) {
#pragma unroll
                    for (int s = 0; s < 2; ++s) { *(LAS u32x4*)(lds + ((cur ^ 1) * 2 + s) * BUFB + kst) = kreg[s]; *(LAS u32x4*)(lds + ((cur ^ 1) * 2 + s) * BUFB + vst) = vreg[s]; }
                }
                if (lane == 0) votes[cur * 8 + wid] = __all(Rp == 0.f) ? 1u : 0u;
                __syncthreads();
                { const u32x4 v0 = *(const LAS u32x4*)(votes + cur * 8), v1 = *(const LAS u32x4*)(votes + cur * 8 + 4);
                  if ((v0.x & v0.y & v0.z & v0.w & v1.x & v1.y & v1.z & v1.w) != 0u) break; }
                cur ^= 1;
            }
            __syncthreads();
            { LAS unsigned char* stg = lds + 73728 + wid * 4352;
#pragma unroll
              for (int c = 0; c < 2; ++c)
#pragma unroll
                for (int g = 0; g < 4; ++g) { u32x2 w; w.x = pg8::cvt_pk_bf16(o[c][4 * g], o[c][4 * g + 1]); w.y = pg8::cvt_pk_bf16(o[c][4 * g + 2], o[c][4 * g + 3]);
                    *(LAS u32x2*)(stg + r32 * 136 + 64 * c + 16 * g + 8 * hi) = w; }
              LDS_WAIT();
              bf16_t* Ob = O + (rowbase + tq0) * DM + h * 64;
#pragma unroll
              for (int k = 0; k < 4; ++k) { const int pc = lane + 64 * k, rw = pc >> 3, pp = pc & 7;
                  const u32x2 v0 = *(const LAS u32x2*)(stg + rw * 136 + pp * 16), v1 = *(const LAS u32x2*)(stg + rw * 136 + pp * 16 + 8);
                  *(u32x4*)(Ob + (size_t)rw * DM + pp * 8) = (u32x4){v0.x, v0.y, v1.x, v1.y}; }
              LDS_WAIT(); }
        }
    }
}

__device__ __forceinline__ unsigned sortkey(float v) { const unsigned u = __builtin_bit_cast(unsigned, v + 0.f);
    return (u & 0x80000000u) ? ~u : (u | 0x80000000u); }
__device__ __forceinline__ void indexer_phase(const bf16_t* PJ, float* rk, unsigned short* SEL, LAS unsigned char* lds) {
    const int tid = fresh_tid(), lane = tid & 63, r32 = lane & 31, hi = lane >> 5;
    const int wid = __builtin_amdgcn_readfirstlane(tid >> 6);
    { const int gw = blockIdx.x * NWAVE + wid, NGW = gridDim.x * NWAVE;
#pragma unroll 4
      for (int t4 = gw; t4 < TOK / 4; t4 += NGW) { const int tok = 4 * t4 + (lane >> 4);
          const u32x4 w = *(const u32x4*)(PJ + (size_t)tok * PROJ_LD + PJ_LAT + 8 * (lane & 15));
          float ss = bflo(w.x) * bflo(w.x) + bfhi(w.x) * bfhi(w.x) + bflo(w.y) * bflo(w.y) + bfhi(w.y) * bfhi(w.y) + bflo(w.z) * bflo(w.z) + bfhi(w.z) * bfhi(w.z) + bflo(w.w) * bflo(w.w) + bfhi(w.w) * bfhi(w.w);
          ss += __shfl_xor(ss, 1); ss += __shfl_xor(ss, 2); ss += __shfl_xor(ss, 4); ss += __shfl_xor(ss, 8);
          if ((lane & 15) == 0) rk[tok] = rsqrtf(ss * (1.f / 128.f) + RMS_EPS); } }
    constexpr int AUX0 = 131072, AUXW = 3072;
    LAS unsigned* hist = (LAS unsigned*)(lds + AUX0 + wid * AUXW);
    LAS unsigned short* listA = (LAS unsigned short*)(lds + AUX0 + wid * AUXW + 2080);
    LAS float* pmm = (LAS float*)(lds + AUX0 + NWAVE * AUXW);
    for (int gl = blockIdx.x; gl < TOK / 8; gl += gridDim.x) {
        const int b = gl >> 9, jj = gl & 511, t0 = (jj < 256 ? jj : 767 - jj) * 8;
        const size_t rowbase = (size_t)b * SEQ;
        const int t = t0 + wid;
        unsigned short* selrow = SEL + (rowbase + t) * 256;
        if (t0 + 7 < 256) {
#pragma unroll
            for (int i = 0; i < 4; ++i) { const int s = lane + 64 * i; selrow[s] = (unsigned short)(s <= t ? s : 0); }
            continue;
        }
        {
            const int g = r32 >> 3, hp = (r32 >> 2) & 1, ii = r32 & 3, tq = 2 * hp + (g >> 1), head = 4 * (g & 1) + ii;
            bf16x8 af[2][4]; float wq[2][2][8];
#pragma unroll
            for (int rt = 0; rt < 2; ++rt) {
                const bf16_t* qp = PJ + (rowbase + t0 + 4 * rt + tq) * PROJ_LD + PJ_QI + head * 64 + hi * 8;
#pragma unroll
                for (int kk = 0; kk < 4; ++kk) af[rt][kk] = *(const bf16x8*)(qp + kk * 16);
#pragma unroll
                for (int qq = 0; qq < 2; ++qq) { const u32x4 w = *(const u32x4*)(PJ + (rowbase + t0 + 4 * rt + 2 * hi + qq) * PROJ_LD + PJ_WI);
                    const float sc = 0.35355339059327373f;
                    wq[rt][qq][0] = bflo(w.x) * sc; wq[rt][qq][1] = bfhi(w.x) * sc; wq[rt][qq][2] = bflo(w.y) * sc; wq[rt][qq][3] = bfhi(w.y) * sc;
                    wq[rt][qq][4] = bflo(w.z) * sc; wq[rt][qq][5] = bfhi(w.z) * sc; wq[rt][qq][6] = bflo(w.w) * sc; wq[rt][qq][7] = bfhi(w.w) * sc; }
            }
            float rmax[2][2], rmin[2][2];
#pragma unroll
            for (int rt = 0; rt < 2; ++rt)
#pragma unroll
                for (int qq = 0; qq < 2; ++qq) { rmax[rt][qq] = -INFINITY; rmin[rt][qq] = INFINITY; }
            const int nkt = (t0 + 8 + 31) >> 5;
            const bf16_t* kbase = PJ + (rowbase + r32) * PROJ_LD + PJ_KI + hi * 8;
            bf16x8 bcur[4], bnxt[4];
            int kt = wid;
#pragma unroll
            for (int kk = 0; kk < 4; ++kk) bcur[kk] = *(const bf16x8*)(kbase + (size_t)(32 * kt) * PROJ_LD + kk * 16);
#pragma unroll 1
            while (kt < nkt) {
                const int kn = kt + NWAVE;
                if (kn < nkt) {
#pragma unroll
                    for (int kk = 0; kk < 4; ++kk) bnxt[kk] = *(const bf16x8*)(kbase + (size_t)(32 * kn) * PROJ_LD + kk * 16);
                }
                const int key = 32 * kt + r32;
#pragma unroll
                for (int rt = 0; rt < 2; ++rt) {
                    f32x16 acc = f32x16{};
#pragma unroll
                    for (int kk = 0; kk < 4; ++kk) acc = __builtin_amdgcn_mfma_f32_32x32x16_bf16(af[rt][kk], bcur[kk], acc, 0, 0, 0);
#pragma unroll
                    for (int qq = 0; qq < 2; ++qq) { float s = 0.f;
#pragma unroll
                        for (int e = 0; e < 8; ++e) s += wq[rt][qq][e] * fmaxf(acc[8 * qq + e], 0.f);
                        ((LAS float*)lds)[(4 * rt + 2 * hi + qq) * 4096 + key] = s;
                        const bool ok = key <= t0 + 4 * rt + 2 * hi + qq;
                        rmax[rt][qq] = fmaxf(rmax[rt][qq], ok ? s : -INFINITY); rmin[rt][qq] = fminf(rmin[rt][qq], ok ? s : INFINITY); }
                }
#pragma unroll
                for (int kk = 0; kk < 4; ++kk) bcur[kk] = bnxt[kk];
                kt = kn;
            }
#pragma unroll
            for (int rt = 0; rt < 2; ++rt)
#pragma unroll
                for (int qq = 0; qq < 2; ++qq) {
#pragma unroll
                    for (int o = 1; o < 32; o <<= 1) { rmax[rt][qq] = fmaxf(rmax[rt][qq], __shfl_xor(rmax[rt][qq], o)); rmin[rt][qq] = fminf(rmin[rt][qq], __shfl_xor(rmin[rt][qq], o)); }
                    if (r32 == 0) { pmm[(wid * 8 + 4 * rt + 2 * hi + qq) * 2] = rmax[rt][qq]; pmm[(wid * 8 + 4 * rt + 2 * hi + qq) * 2 + 1] = rmin[rt][qq]; } }
        }
        __syncthreads();
        {
            const LAS float* row = (const LAS float*)lds + wid * 4096;
            float vmax = -INFINITY, vmin = INFINITY;
#pragma unroll
            for (int w = 0; w < NWAVE; ++w) { vmax = fmaxf(vmax, pmm[(w * 8 + wid) * 2]); vmin = fminf(vmin, pmm[(w * 8 + wid) * 2 + 1]); }
            const int nI4 = (t >> 8) + 1;
            float lo = vmin, sc = (vmax > vmin) ? 511.f / (vmax - vmin) : 0.f;
            float lo0 = 0.f, sc0 = 0.f, lo1 = 0.f, sc1 = 0.f; int b0 = 0, b1 = 0;
            unsigned need = 256u, base = 0u;
            bool by_index = false;
            LAS unsigned* cl = hist;
#define BINL(x, l, s) min((int)(((x) - (l)) * (s)), 511)
#define ACTIVE(x, idx) (((idx) <= t) & ((lev < 1) | (BINL(x, lo0, sc0) == b0)) & ((lev < 2) | (BINL(x, lo1, sc1) == b1)))
#pragma unroll 1
            for (int lev = 0; ; ++lev) {
#pragma unroll
                for (int i = 0; i < 9; ++i) if (lane + 64 * i < 520) hist[lane + 64 * i] = 0u;
                if (lev == 0) {
#pragma unroll 2
                    for (int i = 0; i < nI4; ++i) { const f32x4 x4 = *(const LAS f32x4*)(row + 256 * i + 4 * lane);
#pragma unroll
                        for (int e = 0; e < 4; ++e) { const int idx = 256 * i + 4 * lane + e; const int bn = (idx <= t) ? BINL(x4[e], lo, sc) : 512 + (lane & 7);
                            __hip_atomic_fetch_add(hist + bn, 1u, __ATOMIC_RELAXED, __HIP_MEMORY_SCOPE_WORKGROUP); } }
                } else {
#pragma unroll 2
                for (int i = 0; i < nI4; ++i) { const f32x4 x4 = *(const LAS f32x4*)(row + 256 * i + 4 * lane);
#pragma unroll
                    for (int e = 0; e < 4; ++e) { const int idx = 256 * i + 4 * lane + e; const float ve = by_index ? -(float)idx : x4[e]; const int bn = ACTIVE(x4[e], idx) ? BINL(ve, lo, sc) : 512 + (lane & 7);
                        __hip_atomic_fetch_add(hist + bn, 1u, __ATOMIC_RELAXED, __HIP_MEMORY_SCOPE_WORKGROUP); } }
                }
                LDS_WAIT();
                unsigned c[8]; unsigned lsum = 0;
                { const u32x4 h0 = *(const LAS u32x4*)(hist + 8 * lane), h1 = *(const LAS u32x4*)(hist + 8 * lane + 4);
                  c[0] = h0.x; c[1] = h0.y; c[2] = h0.z; c[3] = h0.w; c[4] = h1.x; c[5] = h1.y; c[6] = h1.z; c[7] = h1.w; }
#pragma unroll
                for (int i = 0; i < 8; ++i) lsum += c[i];
                unsigned sfx = lsum;
#pragma unroll
                for (int o = 1; o < 64; o <<= 1) { const unsigned x = __shfl_down(sfx, o); if (lane + o < 64) sfx += x; }
                unsigned cum = sfx - lsum; int bst = -1; unsigned cab = 0, ceq = 0;
#pragma unroll
                for (int i = 7; i >= 0; --i) { if (cum < need && cum + c[i] >= need) { bst = 8 * lane + i; cab = cum; ceq = c[i]; } cum += c[i]; }
                const unsigned long long bm = __ballot(bst >= 0);
                const int src = __builtin_amdgcn_readfirstlane((int)__builtin_ctzll(bm));
                const int bstar = __builtin_amdgcn_readfirstlane(__shfl(bst, src));
                const unsigned cnt_above = (unsigned)__builtin_amdgcn_readfirstlane((int)__shfl(cab, src)), cnt_eq = (unsigned)__builtin_amdgcn_readfirstlane((int)__shfl(ceq, src));
                need -= cnt_above;
                LDS_WAIT();
                const bool fast = cnt_eq <= 64u;
                unsigned cb2 = 0; float amax = -INFINITY, amin = INFINITY;
                if (lev == 0) {
#pragma unroll 1
                for (int i = 0; i < nI4; ++i) { const f32x4 x4 = *(const LAS f32x4*)(row + 256 * i + 4 * lane);
                    const int idx0 = 256 * i + 4 * lane;
                    bool sv[4], ev[4]; float vv[4]; unsigned ns = 0;
#pragma unroll
                    for (int e = 0; e < 4; ++e) { const int idx = idx0 + e; const bool act = idx <= t; vv[e] = x4[e]; const int bn = BINL(vv[e], lo, sc);
                        sv[e] = act & (bn > bstar); ev[e] = act & (bn == bstar); ns += sv[e] ? 1u : 0u; }
                    const unsigned long long m1 = __ballot(ns & 1u), m2 = __ballot(ns & 2u), m4 = __ballot(ns & 4u);
                    unsigned pos = base + __builtin_amdgcn_mbcnt_hi((unsigned)(m1 >> 32), __builtin_amdgcn_mbcnt_lo((unsigned)m1, 0u))
                                        + 2u * __builtin_amdgcn_mbcnt_hi((unsigned)(m2 >> 32), __builtin_amdgcn_mbcnt_lo((unsigned)m2, 0u))
                                        + 4u * __builtin_amdgcn_mbcnt_hi((unsigned)(m4 >> 32), __builtin_amdgcn_mbcnt_lo((unsigned)m4, 0u));
                    base += (unsigned)__builtin_popcountll(m1) + 2u * (unsigned)__builtin_popcountll(m2) + 4u * (unsigned)__builtin_popcountll(m4);
#pragma unroll
                    for (int e = 0; e < 4; ++e) { listA[sv[e] ? pos : 256u + (unsigned)lane] = (unsigned short)(idx0 + e); pos += sv[e] ? 1u : 0u; }
                    const bool anye = ev[0] | ev[1] | ev[2] | ev[3];
                    if (fast) {
                        if (__ballot(anye) != 0ull) {
#pragma unroll
                            for (int e = 0; e < 4; ++e) { const unsigned long long me = __ballot(ev[e]);
                                if (ev[e]) { const unsigned cp = cb2 + __builtin_amdgcn_mbcnt_hi((unsigned)(me >> 32), __builtin_amdgcn_mbcnt_lo((unsigned)me, 0u)); cl[cp] = (unsigned)(idx0 + e); cl[64 + cp] = __builtin_bit_cast(unsigned, vv[e]); }
                                cb2 += (unsigned)__builtin_popcountll(me); } }
                    } else {
#pragma unroll
                        for (int e = 0; e < 4; ++e) { amax = fmaxf(amax, ev[e] ? vv[e] : -INFINITY); amin = fminf(amin, ev[e] ? vv[e] : INFINITY); }
                    } }
                } else {
#pragma unroll 1
                for (int i = 0; i < nI4; ++i) { const f32x4 x4 = *(const LAS f32x4*)(row + 256 * i + 4 * lane);
                    const int idx0 = 256 * i + 4 * lane;
                    bool sv[4], ev[4]; float vv[4]; unsigned ns = 0;
#pragma unroll
                    for (int e = 0; e < 4; ++e) { const int idx = idx0 + e; const bool act = ACTIVE(x4[e], idx); vv[e] = by_index ? -(float)idx : x4[e]; const int bn = BINL(vv[e], lo, sc);
                        sv[e] = act & (bn > bstar); ev[e] = act & (bn == bstar); ns += sv[e] ? 1u : 0u; }
                    const unsigned long long m1 = __ballot(ns & 1u), m2 = __ballot(ns & 2u), m4 = __ballot(ns & 4u);
                    unsigned pos = base + __builtin_amdgcn_mbcnt_hi((unsigned)(m1 >> 32), __builtin_amdgcn_mbcnt_lo((unsigned)m1, 0u))
                                        + 2u * __builtin_amdgcn_mbcnt_hi((unsigned)(m2 >> 32), __builtin_amdgcn_mbcnt_lo((unsigned)m2, 0u))
                                        + 4u * __builtin_amdgcn_mbcnt_hi((unsigned)(m4 >> 32), __builtin_amdgcn_mbcnt_lo((unsigned)m4, 0u));
                    base += (unsigned)__builtin_popcountll(m1) + 2u * (unsigned)__builtin_popcountll(m2) + 4u * (unsigned)__builtin_popcountll(m4);
#pragma unroll
                    for (int e = 0; e < 4; ++e) { listA[sv[e] ? pos : 256u + (unsigned)lane] = (unsigned short)(idx0 + e); pos += sv[e] ? 1u : 0u; }
                    const bool anye = ev[0] | ev[1] | ev[2] | ev[3];
                    if (fast) {
                        if (__ballot(anye) != 0ull) {
#pragma unroll
                            for (int e = 0; e < 4; ++e) { const unsigned long long me = __ballot(ev[e]);
                                if (ev[e]) { const unsigned cp = cb2 + __builtin_amdgcn_mbcnt_hi((unsigned)(me >> 32), __builtin_amdgcn_mbcnt_lo((unsigned)me, 0u)); cl[cp] = (unsigned)(idx0 + e); cl[64 + cp] = __builtin_bit_cast(unsigned, vv[e]); }
                                cb2 += (unsigned)__builtin_popcountll(me); } }
                    } else {
#pragma unroll
                        for (int e = 0; e < 4; ++e) { amax = fmaxf(amax, ev[e] ? vv[e] : -INFINITY); amin = fminf(amin, ev[e] ? vv[e] : INFINITY); }
                    } }
                }
                if (fast) {
                    LDS_WAIT();
                    const bool have = (unsigned)lane < cnt_eq;
                    const unsigned myi = have ? cl[lane] : 0xffffffffu; const float myv = have ? __builtin_bit_cast(float, cl[64 + lane]) : -INFINITY;
                    unsigned rank = 0;
                    for (unsigned j2 = 0; j2 < cnt_eq; ++j2) { const float vj = __shfl(myv, (int)j2); const unsigned ij = __shfl(myi, (int)j2); rank += (vj > myv || (vj == myv && ij < myi)) ? 1u : 0u; }
                    const bool s = have && rank < need; const unsigned long long m = __ballot(s);
                    if (s) listA[base + __builtin_amdgcn_mbcnt_hi((unsigned)(m >> 32), __builtin_amdgcn_mbcnt_lo((unsigned)m, 0u))] = (unsigned short)myi;
                    break;
                }
#pragma unroll
                for (int o = 1; o < 64; o <<= 1) { amax = fmaxf(amax, __shfl_xor(amax, o)); amin = fminf(amin, __shfl_xor(amin, o)); }
                if (lev < 2 && !by_index) {
                    if (lev == 0) { lo0 = lo; sc0 = sc; b0 = bstar; } else { lo1 = lo; sc1 = sc; b1 = bstar; }
                    if (amax > amin) { lo = amin; sc = 511.f / (amax - amin); }
                    else { by_index = true; lo = -(float)t; sc = 511.f / (float)t; }
                    continue;
                }
                {
                    const int nI = (t >> 6) + 1;
                    const unsigned kmin = sortkey(amin), kmax = sortkey(amax), kdiff = kmin ^ kmax; const int nb = kdiff ? 32 - __builtin_clz(kdiff) : 0;
                    unsigned tau = nb >= 32 ? 0u : ((kmax >> nb) << nb);
#define CAND(x, idx) (ACTIVE(x, idx) && BINL(x, lo, sc) == bstar)
#pragma unroll 1
                    for (int bit = nb - 1; bit >= 0; --bit) { const unsigned trial = tau | (1u << bit); unsigned cnt = 0;
#pragma unroll 2
                        for (int i = 0; i < nI; ++i) { const int idx = lane + 64 * i; const float x = row[idx]; cnt += (CAND(x, idx) && sortkey(x) >= trial) ? 1u : 0u; }
#pragma unroll
                        for (int o = 1; o < 64; o <<= 1) cnt += __shfl_xor(cnt, o);
                        if (cnt >= need) tau = trial; }
                    unsigned cg = 0;
#pragma unroll 2
                    for (int i = 0; i < nI; ++i) { const int idx = lane + 64 * i; const float x = row[idx]; cg += (CAND(x, idx) && sortkey(x) > tau) ? 1u : 0u; }
#pragma unroll
                    for (int o = 1; o < 64; o <<= 1) cg += __shfl_xor(cg, o);
                    unsigned ties = need - cg;
#pragma unroll 1
                    for (int i = 0; i < nI; ++i) { const int idx = lane + 64 * i; const float x = row[idx]; const bool cand = CAND(x, idx); const unsigned kx = sortkey(x);
                        const bool gt = cand && kx > tau, eq = cand && kx == tau; const unsigned long long me = __ballot(eq);
                        const unsigned eoff = __builtin_amdgcn_mbcnt_hi((unsigned)(me >> 32), __builtin_amdgcn_mbcnt_lo((unsigned)me, 0u));
                        const bool s = gt || (eq && eoff < ties); const unsigned long long m = __ballot(s);
                        if (s) listA[base + __builtin_amdgcn_mbcnt_hi((unsigned)(m >> 32), __builtin_amdgcn_mbcnt_lo((unsigned)m, 0u))] = (unsigned short)idx;
                        base += (unsigned)__builtin_popcountll(m); const unsigned ne = (unsigned)__builtin_popcountll(me); ties = ties > ne ? ties - ne : 0u; }
#undef CAND
                    break;
                }
            }
#undef ACTIVE
#undef BINL
            LDS_WAIT();
            *(u32x2*)(selrow + 4 * lane) = *(const LAS u32x2*)(listA + 4 * lane);
        }
        __syncthreads();
    }
}

__device__ __forceinline__ unsigned off_b(unsigned row, unsigned ch) { return 256u * row + 16u * (ch ^ (((row & 3) << 2) | ((row >> 2) & 3))); }
__device__ __forceinline__ void dsa_attn_phase(const bf16_t* PJ, const float* rk, const unsigned short* SEL, const float* biasd, const float* qg, const float* kg, bf16_t* OL, LAS unsigned char* lds) {
    const int tid = fresh_tid(), lane = tid & 63, c16 = lane & 15, G = lane >> 4;
    const int wid = __builtin_amdgcn_readfirstlane(tid >> 6);
    LAS float* biasS = (LAS float*)(lds + 135168);
    for (int e = tid; e < 2048; e += NTHR) biasS[e] = biasd[e];
    if (tid < 16) biasS[2048 + tid] = -INFINITY;
    __syncthreads();
    LAS unsigned char* tile = lds + wid * 16896;
    LAS int* selS = (LAS int*)(tile + 16384);
    LAS float* rS = (LAS float*)(tile + 16384 + 256);
    const int gw = blockIdx.x * NWAVE + wid, NGW = gridDim.x * NWAVE;
    float bmax = -INFINITY;
#pragma unroll 4
    for (int d = G * 32; d < G * 32 + 32; ++d) bmax = fmaxf(bmax, biasS[d * 16 + c16]);
    bmax = fmaxf(bmax, __shfl_xor(bmax, 16)); bmax = fmaxf(bmax, __shfl_xor(bmax, 32));
    u32x4 selreg = (u32x4){0u, 0u, 0u, 0u};
    if (gw < TOK) { const unsigned short* sp = SEL + (size_t)gw * 256 + lane; selreg = (u32x4){sp[0], sp[64], sp[128], sp[192]}; }
#pragma unroll 1
    for (int qi = gw; qi < TOK; qi += NGW) {
        const int b = qi >> 12, t = qi & 4095;
        const size_t rowbase = (size_t)b * SEQ;
        const int count = (t + 1 < 256) ? t + 1 : 256;
        const int nch = (count + 63) >> 6;
        const bf16_t* latb = PJ + rowbase * PROJ_LD + PJ_LAT + c16 * 8;
        int sl = (lane < count) ? (int)selreg[0] : 0;
        float rkv = rk[rowbase + sl];
        u32x4 gr[16];
#pragma unroll
        for (int i = 0; i < 16; ++i) { const int srow = __shfl(sl, 4 * i + G); gr[i] = *(const u32x4*)(latb + (size_t)srow * PROJ_LD); }
        bf16x8 qf[4]; float mshift;
        {
            float qv[4][8]; float ss = 0.f;
#pragma unroll
            for (int kk = 0; kk < 4; ++kk) { const u32x4 w = *(const u32x4*)(PJ + (rowbase + t) * PROJ_LD + c16 * 128 + 32 * kk + 8 * G);
                qv[kk][0] = bflo(w.x); qv[kk][1] = bfhi(w.x); qv[kk][2] = bflo(w.y); qv[kk][3] = bfhi(w.y); qv[kk][4] = bflo(w.z); qv[kk][5] = bfhi(w.z); qv[kk][6] = bflo(w.w); qv[kk][7] = bfhi(w.w);
#pragma unroll
                for (int j = 0; j < 8; ++j) ss += qv[kk][j] * qv[kk][j]; }
            ss += __shfl_xor(ss, 16); ss += __shfl_xor(ss, 32);
            const float rinv = rsqrtf(ss * (1.f / 128.f) + RMS_EPS) * (0.08838834764831845f * LOG2E);
            float qn = 0.f;
#pragma unroll
            for (int kk = 0; kk < 4; ++kk) { const int d = 32 * kk + 8 * G;
                const f32x4 g0 = *(const f32x4*)(qg + d), g1 = *(const f32x4*)(qg + d + 4), h0 = *(const f32x4*)(kg + d), h1 = *(const f32x4*)(kg + d + 4);
                u32x4 w; w.x = pg8::cvt_pk_bf16(qv[kk][0] * rinv * g0[0] * h0[0], qv[kk][1] * rinv * g0[1] * h0[1]); w.y = pg8::cvt_pk_bf16(qv[kk][2] * rinv * g0[2] * h0[2], qv[kk][3] * rinv * g0[3] * h0[3]);
                w.z = pg8::cvt_pk_bf16(qv[kk][4] * rinv * g1[0] * h1[0], qv[kk][5] * rinv * g1[1] * h1[1]); w.w = pg8::cvt_pk_bf16(qv[kk][6] * rinv * g1[2] * h1[2], qv[kk][7] * rinv * g1[3] * h1[3]);
                qf[kk] = __builtin_bit_cast(bf16x8, w);
                qn += bflo(w.x) * bflo(w.x) + bfhi(w.x) * bfhi(w.x) + bflo(w.y) * bflo(w.y) + bfhi(w.y) * bfhi(w.y) + bflo(w.z) * bflo(w.z) + bfhi(w.z) * bfhi(w.z) + bflo(w.w) * bflo(w.w) + bfhi(w.w) * bfhi(w.w); }
            qn += __shfl_xor(qn, 16); qn += __shfl_xor(qn, 32);
            mshift = sqrtf(qn) * 11.313708498984761f * 1.01f + bmax;
        }
        f32x4 o[8];
#pragma unroll
        for (int dt = 0; dt < 8; ++dt) o[dt] = (f32x4){0.f, 0.f, 0.f, 0.f};
        float lrun = 0.f;
        u32x4 selnext = selreg;
#pragma unroll 1
        for (int ch = 0; ch < nch; ++ch) {
            { const bool vk = ch * 64 + lane < count; int dist = t - sl; dist = dist < 0 ? 0 : (dist > 127 ? 127 : dist);
              selS[lane] = vk ? dist * 16 : 2048; rS[lane] = vk ? rkv : 0.f; }
#pragma unroll
            for (int i = 0; i < 16; ++i) *(LAS u32x4*)(tile + off_b(4 * i + G, c16)) = gr[i];
            if (ch + 1 < nch) {
                const unsigned sv = (ch == 0) ? selreg[1] : (ch == 1) ? selreg[2] : selreg[3];
                sl = ((ch + 1) * 64 + lane < count) ? (int)sv : 0;
                rkv = rk[rowbase + sl];
#pragma unroll
                for (int i = 0; i < 16; ++i) { const int srow = __shfl(sl, 4 * i + G); gr[i] = *(const u32x4*)(latb + (size_t)srow * PROJ_LD); }
            } else if (qi + NGW < TOK) {
                const unsigned short* sp = SEL + (size_t)(qi + NGW) * 256 + lane; selnext = (u32x4){sp[0], sp[64], sp[128], sp[192]};
            }
            LDS_WAIT();
            float pl[4][4];
#pragma unroll
            for (int kt4 = 0; kt4 < 4; ++kt4) {
                const unsigned arow = 32 * (kt4 >> 1) + 8 * (c16 >> 2) + 4 * (kt4 & 1) + (c16 & 3);
                f32x4 acc = (f32x4){0.f, 0.f, 0.f, 0.f};
#pragma unroll
                for (int kk = 0; kk < 4; ++kk) { const bf16x8 a = *(const LAS bf16x8*)(tile + off_b(arow, 4 * kk + G)); acc = __builtin_amdgcn_mfma_f32_16x16x32_bf16(a, qf[kk], acc, 0, 0, 0); }
                const int rho = 32 * (kt4 >> 1) + 8 * G + 4 * (kt4 & 1);
                const u32x4 s4 = *(const LAS u32x4*)(selS + rho); const f32x4 r4 = *(const LAS f32x4*)(rS + rho);
#pragma unroll
                for (int reg = 0; reg < 4; ++reg) { const float lg = acc[reg] * r4[reg] + biasS[(int)s4[reg] + c16];
                    pl[kt4][reg] = __builtin_amdgcn_exp2f(lg - mshift); lrun += pl[kt4][reg]; }
            }
            bf16x8 pf[2];
#pragma unroll
            for (int ks = 0; ks < 2; ++ks) { u32x4 w; w.x = pg8::cvt_pk_bf16(pl[2 * ks][0], pl[2 * ks][1]); w.y = pg8::cvt_pk_bf16(pl[2 * ks][2], pl[2 * ks][3]);
                w.z = pg8::cvt_pk_bf16(pl[2 * ks + 1][0], pl[2 * ks + 1][1]); w.w = pg8::cvt_pk_bf16(pl[2 * ks + 1][2], pl[2 * ks + 1][3]); pf[ks] = __builtin_bit_cast(bf16x8, w); }
            const unsigned q4 = (lane & 15) >> 2, p4 = lane & 3;
#pragma unroll
            for (int dt = 0; dt < 8; ++dt) {
#pragma unroll
                for (int ks = 0; ks < 2; ++ks) {
                    const s16x4 lo = __builtin_bit_cast(s16x4, __builtin_amdgcn_ds_read_tr16_b64_v4i16((LAS s16x4*)(tile + off_b(32 * ks + 8 * G + q4, 2 * dt + (p4 >> 1)) + 8 * (p4 & 1))));
                    const s16x4 hh = __builtin_bit_cast(s16x4, __builtin_amdgcn_ds_read_tr16_b64_v4i16((LAS s16x4*)(tile + off_b(32 * ks + 8 * G + 4 + q4, 2 * dt + (p4 >> 1)) + 8 * (p4 & 1))));
                    const bf16x8 vf = (bf16x8){lo[0], lo[1], lo[2], lo[3], hh[0], hh[1], hh[2], hh[3]};
                    o[dt] = __builtin_amdgcn_mfma_f32_16x16x32_bf16(vf, pf[ks], o[dt], 0, 0, 0);
                }
            }
            LDS_WAIT();
        }
        selreg = selnext;
        lrun += __shfl_xor(lrun, 16); lrun += __shfl_xor(lrun, 32);
        const float inv = 1.f / lrun;
        bf16_t* op = OL + (rowbase + t) * 2048 + c16 * 128 + 4 * G;
#pragma unroll
        for (int dt = 0; dt < 8; ++dt) { u32x2 w; w.x = pg8::cvt_pk_bf16(o[dt][0] * inv, o[dt][1] * inv); w.y = pg8::cvt_pk_bf16(o[dt][2] * inv, o[dt][3] * inv); *(u32x2*)(op + 16 * dt) = w; }
    }
}

template <class Epi> __device__ __forceinline__ void run_gemm(LAS unsigned char* lds, const bf16_t* A, const bf16_t* Bt, int N, int K, const Epi& E) {
    pg8::Gemm g{A, Bt, TOK, N, K}; pg8::StaticOrder S; S.init(TOK, N, (int)gridDim.x, (int)blockIdx.x);
    pg8::gemm_phase<Epi, pg8::StaticOrder, true, true>(lds, g, S, E);
}

#define RLX_AGENT __ATOMIC_RELAXED, __HIP_MEMORY_SCOPE_AGENT
#define XB_TMO      128
#define XB_XCNT(j)  (256  + 64 * (j))
#define XB_XSUB(j)  (1280 + 64 * (j))
#define XB_XGEN(j)  (2304 + 64 * (j))
#define XB_TOP      3328
#define XB_TOPGEN   3392
#define XCD_BAR_WORDS 3456
#define XB_SPIN_CAP (1u << 18)

__device__ __forceinline__ unsigned xb_ld(unsigned* p)              { return __hip_atomic_load(p, __ATOMIC_RELAXED, __HIP_MEMORY_SCOPE_AGENT); }
__device__ __forceinline__ unsigned xb_add(unsigned* p, unsigned v) { return __hip_atomic_fetch_add(p, v, __ATOMIC_RELAXED, __HIP_MEMORY_SCOPE_AGENT); }
__device__ __forceinline__ unsigned xb_xcc_id() { return (unsigned)__builtin_amdgcn_s_getreg((3 << 11) | 20) & 0xFu; }
#define XB_SPIN(cond, bar) do { unsigned _sp = 0; while (cond) { __builtin_amdgcn_s_sleep(1); \
    if ((++_sp & 255u) == 0u) { if (xb_ld(&(bar)[XB_TMO])) break; if (_sp > XB_SPIN_CAP) { atomicAdd(&(bar)[XB_TMO], 1u); break; } } } } while (0)

struct XcdBarrier {
    unsigned* bar; unsigned x;
    volatile LAS unsigned* st;
};

__device__ __forceinline__ XcdBarrier xcd_barrier_post(unsigned* bar, volatile LAS unsigned* st) {
    XcdBarrier b; b.bar = bar; b.x = xb_xcc_id(); b.st = st;
    if (threadIdx.x == 0) (void)xb_add(&bar[XB_XCNT(b.x)], 1u);
    return b;
}
__device__ __forceinline__ void xcd_barrier_complete(unsigned* bar, unsigned x, unsigned& nloc, unsigned& nx) {
    const unsigned G = gridDim.x * gridDim.y * gridDim.z;
    unsigned sum, cnt, mine, sp = 0u;
    for (;;) {
        sum = 0u; cnt = 0u; mine = 0u;
#pragma unroll
        for (unsigned j = 0; j < 16; ++j) { const unsigned c = xb_ld(&bar[XB_XCNT(j)]); sum += c; cnt += (c > 0u) ? 1u : 0u; mine = (j == x) ? c : mine; }
        if (sum == G) break;
        __builtin_amdgcn_s_sleep(1);
        if ((++sp & 255u) == 0u) { if (xb_ld(&bar[XB_TMO])) break; if (sp > XB_SPIN_CAP) { atomicAdd(&bar[XB_TMO], 1u); break; } }
    }
    nloc = mine > 0u ? mine : 1u; nx = cnt > 0u ? cnt : 1u;
}

__device__ __forceinline__ void xcd_barrier(const XcdBarrier& b) {
    asm volatile("s_waitcnt vmcnt(0)" ::: "memory");
    __syncthreads();
    if (threadIdx.x == 0) {
        unsigned* bar = b.bar;
        __builtin_amdgcn_s_waitcnt(0);
        unsigned nloc = b.st[0], nx = b.st[1];
        if (nloc == 0u) { xcd_barrier_complete(bar, b.x, nloc, nx); b.st[0] = nloc; b.st[1] = nx; }
        const unsigned old = xb_add(&bar[XB_XSUB(b.x)], 1u);
        const unsigned gen = old / nloc;
        if (old + 1u == (gen + 1u) * nloc) {
            __builtin_amdgcn_fence(__ATOMIC_RELEASE, "agent");
            asm volatile("s_waitcnt vmcnt(0)" ::: "memory");
            const unsigned og = xb_add(&bar[XB_TOP], 1u);
            const unsigned tg = og / nx;
            if (og + 1u == (tg + 1u) * nx) xb_add(&bar[XB_TOPGEN], 1u);
            else XB_SPIN(xb_ld(&bar[XB_TOPGEN]) == tg, bar);
            __builtin_amdgcn_fence(__ATOMIC_ACQUIRE, "agent");
            xb_add(&bar[XB_XGEN(b.x)], 1u);
            asm volatile("s_waitcnt vmcnt(0)" ::: "memory");
        } else {
            XB_SPIN(xb_ld(&bar[XB_XGEN(b.x)]) == gen, bar);
            __builtin_amdgcn_fence(__ATOMIC_ACQUIRE, "agent");
            asm volatile("s_waitcnt vmcnt(0)" ::: "memory");
        }
    }
    __syncthreads();
}

typedef const Params __attribute__((address_space(4)))* KArgs;
#define PHASE_BEGIN { KArgs q = (KArgs)__builtin_amdgcn_kernarg_segment_ptr(); asm volatile("" : "+s"(q)); unsigned char* ws = q->ws; (void)ws;
#define PHASE_END } GRID_SYNC();
#define GRID_SYNC() xcd_barrier(bar)
#define WSP(T, off) ((T*)(ws + (off)))
__global__ void __launch_bounds__(NTHR, 2) mega_fwd(Params p_unused) {
    extern __shared__ __attribute__((aligned(16))) unsigned char lds_raw[];
    LAS unsigned char* lds = (LAS unsigned char*)lds_raw;
    cg::grid_group grid = cg::this_grid();
    volatile LAS unsigned* st = (volatile LAS unsigned*)(lds + LDS_PHASE_BYTES);
    if (threadIdx.x < 4) st[threadIdx.x] = 0u;
    __syncthreads();
    XcdBarrier bar;
    { KArgs q = (KArgs)__builtin_amdgcn_kernarg_segment_ptr(); bar = xcd_barrier_post((unsigned*)(q->ws + WS_BAR), st); }

    PHASE_BEGIN { Params p; for (int i = 0; i < 18; ++i) p.in[i] = q->in[i]; p.out = q->out; p.ws = q->ws; p0_prologue(p, lds); }
        if (q->ws == nullptr) grid.sync();
    PHASE_END
    PHASE_BEGIN { Params p; for (int i = 0; i < 18; ++i) p.in[i] = q->in[i]; p.out = q->out; p.ws = q->ws; p0_weights(p, lds); }
        norm_phase(q->in[0], q->in[4], WSP(float, WS_MOD), 0, 1024, WSP(bf16_t, WS_H)); PHASE_END
    PHASE_BEGIN EpiBf16 E{WSP(bf16_t, WS_A), DM, DM, (size_t)TOK * DM, 0.125f * LOG2E}; run_gemm(lds, WSP(bf16_t, WS_H), WSP(bf16_t, WS_WQKV), 3 * DM, DM, E); PHASE_END
    PHASE_BEGIN bf16_t* RA = WSP(bf16_t, WS_A); sb_attn_phase(RA, RA + (size_t)TOK * DM, RA + (size_t)2 * TOK * DM, WSP(bf16_t, WS_B), lds); PHASE_END
    PHASE_BEGIN EpiResid E{q->in[0], q->out, WSP(float, WS_MOD) + 2048}; run_gemm(lds, WSP(bf16_t, WS_B), WSP(bf16_t, WS_WSBO), DM, DM, E); PHASE_END
    PHASE_BEGIN norm_phase(q->out, q->in[5], WSP(float, WS_MOD), 3072, 4096, WSP(bf16_t, WS_H)); PHASE_END
    PHASE_BEGIN EpiConvGate E{WSP(bf16_t, WS_A), WSP(float, WS_HF), WSP(float, WS_HL), q->in[15], q->in[16]}; run_gemm(lds, WSP(bf16_t, WS_H), WSP(bf16_t, WS_WUP0), FFN2, DM, E); PHASE_END
    PHASE_BEGIN fixup_phase(WSP(float, WS_HF), WSP(float, WS_HL), q->in[15], q->in[16], WSP(bf16_t, WS_A)); PHASE_END
    PHASE_BEGIN EpiResid E{q->out, q->out, WSP(float, WS_MOD) + 5120}; run_gemm(lds, WSP(bf16_t, WS_A), WSP(bf16_t, WS_WDN0), DM, FFN, E); PHASE_END
    PHASE_BEGIN norm_phase(q->out, q->in[4] + DM, WSP(float, WS_MOD) + 8 * 6144, 0, 1024, WSP(bf16_t, WS_H)); PHASE_END
    PHASE_BEGIN EpiBf16 E{WSP(bf16_t, WS_A), PROJ_LD, 0, 0, 1.f}; run_gemm(lds, WSP(bf16_t, WS_H), WSP(bf16_t, WS_WDIN), PROJ_LD, DM, E); PHASE_END
    PHASE_BEGIN indexer_phase(WSP(bf16_t, WS_A), WSP(float, WS_RK), WSP(unsigned short, WS_SEL), lds); PHASE_END
    PHASE_BEGIN dsa_attn_phase(WSP(bf16_t, WS_A), WSP(float, WS_RK), WSP(unsigned short, WS_SEL), WSP(float, WS_BIASD), q->in[9], q->in[10], WSP(bf16_t, WS_B), lds); PHASE_END
    PHASE_BEGIN EpiResid E{q->out, q->out, WSP(float, WS_MOD) + 8 * 6144 + 2048}; run_gemm(lds, WSP(bf16_t, WS_B), WSP(bf16_t, WS_WDO), DM, 2 * DM, E); PHASE_END
    PHASE_BEGIN norm_phase(q->out, q->in[5] + DM, WSP(float, WS_MOD) + 8 * 6144, 3072, 4096, WSP(bf16_t, WS_H)); PHASE_END
    PHASE_BEGIN EpiConvGate E{WSP(bf16_t, WS_A), WSP(float, WS_HF), WSP(float, WS_HL), q->in[15] + 3 * FFN2, q->in[16] + FFN2}; run_gemm(lds, WSP(bf16_t, WS_H), WSP(bf16_t, WS_WUP1), FFN2, DM, E); PHASE_END
    PHASE_BEGIN fixup_phase(WSP(float, WS_HF), WSP(float, WS_HL), q->in[15] + 3 * FFN2, q->in[16] + FFN2, WSP(bf16_t, WS_A)); PHASE_END
    { KArgs q = (KArgs)__builtin_amdgcn_kernarg_segment_ptr(); asm volatile("" : "+s"(q)); unsigned char* ws = q->ws;
      EpiResid E{q->out, q->out, WSP(float, WS_MOD) + 8 * 6144 + 5120}; run_gemm(lds, WSP(bf16_t, WS_A), WSP(bf16_t, WS_WDN1), DM, FFN, E); }
}

extern "C" void kernel_launch(void* const* d_in, const int* in_sizes, int n_in, void* d_out, int out_size, void* d_ws, size_t ws_size, hipStream_t stream) {
    static int grid = 0;
    if (grid == 0) {
        if (n_in != 18 || out_size != TOK * DM || ws_size < WS_END) { fprintf(stderr, "kernel_launch: unexpected shapes (n_in %d, out %d, ws %zu)\n", n_in, out_size, ws_size); grid = -1; return; }
        int dev = 0, cus = 0, per_cu = 0;
        hipGetDevice(&dev);
        hipDeviceGetAttribute(&cus, hipDeviceAttributeMultiprocessorCount, dev);
        if (hipFuncSetAttribute((const void*)mega_fwd, hipFuncAttributeMaxDynamicSharedMemorySize, LDS_BYTES) != hipSuccess) { fprintf(stderr, "kernel_launch: hipFuncSetAttribute failed\n"); grid = -1; return; }
        if (hipOccupancyMaxActiveBlocksPerMultiprocessor(&per_cu, (const void*)mega_fwd, NTHR, LDS_BYTES) != hipSuccess || per_cu < 1) { fprintf(stderr, "kernel_launch: occupancy query says %d\n", per_cu); per_cu = 1; }
        (void)hipGetLastError();
        grid = cus * 1;
        fprintf(stderr, "kernel_launch: grid %d (cus %d, per_cu %d)\n", grid, cus, per_cu);
    }
    if (grid < 0) return;
    Params p{};
    for (int i = 0; i < 18; ++i) p.in[i] = (const float*)d_in[i];
    p.out = (float*)d_out; p.ws = (unsigned char*)d_ws;
    void* args[] = {&p};
    if (hipMemsetAsync((char*)d_ws + WS_BAR, 0, XCD_BAR_WORDS * 4, stream) != hipSuccess) { fprintf(stderr, "kernel_launch: memset failed\n"); return; }
    hipError_t e = hipLaunchCooperativeKernel((const void*)mega_fwd, dim3(grid), dim3(NTHR), args, LDS_BYTES, stream);
    if (e != hipSuccess) fprintf(stderr, "cooperative launch failed: %s (grid %d)\n", hipGetErrorString(e), grid);
}
```

```cpp
#include <hip/hip_runtime.h>
#include <hip/hip_cooperative_groups.h>
#include <cstdio>
#include <cstdint>
namespace cg = cooperative_groups;

__device__ __forceinline__ int fresh_tid() { int t = threadIdx.x; asm volatile("" : "+v"(t)); return t; }
namespace pg8 {
#define PG8_LAS __attribute__((address_space(3)))
typedef unsigned short bf16_t;
typedef short bf16x8 __attribute__((ext_vector_type(8)));
typedef float f32x4 __attribute__((ext_vector_type(4)));
typedef unsigned u32x4 __attribute__((ext_vector_type(4)));
constexpr int BM = 256, BK = 64, HALF = 128, HTB = HALF * BK * 2  , STAGE_BYTES = 8 * HTB, NXCD = 8, WGM = 8;

__host__ __device__ __forceinline__ int lds_byte(int r, int c) { const int st = (r >> 4) * 2 + (c >> 5), rr = r & 15, cc = c & 31, ob = rr * 64 + cc * 2; return st * 1024 + (ob ^ (((ob >> 9) & 1) << 5)); }
__host__ __device__ __forceinline__ void stage_rc(int b, int& R, int& C) { const int st = b / 1024, sb = b % 1024, swz = sb ^ (((sb >> 9) & 1) << 5); R = (st >> 1) * 16 + swz / 64; C = (st & 1) * 32 + (swz % 64) / 2; }
__host__ __device__ __forceinline__ int perm32(int rho) { const int n = rho >> 4, i = rho & 15; return 8 * (i >> 2) + 4 * n + (i & 3); }

struct Unit { int pm, pn; };
struct Gemm { const bf16_t* A; const bf16_t* Bt; int M, N, K; };

struct StaticOrder {
    int nM, nN, nwg, G, c;
    __host__ __device__ void init(int M, int N, int G_, int c_) { nM = M / BM; nN = N / BM; nwg = nM * nN; G = G_; c = c_; }
    __host__ __device__ bool next(int i, Unit& u) const {
        const long L = (long)i * G + c; if (L >= nwg) return false;
        int wgid = (int)L; { const int q = nwg / NXCD, r = nwg % NXCD, xcd = wgid % NXCD, off = wgid / NXCD; wgid = (xcd < r ? xcd * (q + 1) : r * (q + 1) + (xcd - r) * q) + off; }
        const int nig = WGM * nN, gid = wgid / nig, fm = gid * WGM, gsz = (nM - fm) < WGM ? (nM - fm) : WGM;
        u.pm = fm + ((wgid % nig) % gsz); u.pn = (wgid % nig) / gsz; return true;
    }
    __device__ __forceinline__ void a_ready(const Unit&) const {}
    __device__ __forceinline__ void done(const Unit&) const {}
};

__device__ __forceinline__ unsigned cvt_pk_bf16(float lo, float hi) { unsigned r; asm volatile("v_cvt_pk_bf16_f32 %0, %1, %2" : "=v"(r) : "v"(lo), "v"(hi)); return r; }
template <class Epi, class Sched, bool ALIGN_EPI = false, bool SP2 = false>
__device__ __forceinline__ void gemm_phase(PG8_LAS unsigned char* lds, const Gemm g, const Sched& S, const Epi& E) {
    const int tid = fresh_tid(), wid = __builtin_amdgcn_readfirstlane(tid >> 6), lane = tid & 63, wr = wid >> 2, wc = wid & 3, fr = lane & 15, fq = lane >> 4;
    const int K = g.K, nt = K / BK;
    unsigned voffA[2], voffB[2];
#pragma unroll
    for (int i = 0; i < 2; ++i) { int R, C; stage_rc(tid * 16 + i * 8192, R, C); const int Rb = Epi::PERM ? ((R & ~31) + perm32(R & 31)) : R;
        voffA[i] = (unsigned)(R * K + C) * 2u; voffB[i] = (unsigned)(Rb * K + C) * 2u; }
    const size_t kstep = (size_t)(BK * 2);
    const size_t hstep = (size_t)HALF * K * 2;
    const size_t tstep = 2 * hstep;
    const unsigned ldsw = (unsigned)wid * 1024u;
    const int aoff = lds_byte(wr * 64 + fr, fq * 8), boff = lds_byte(wc * 32 + fr, fq * 8);
#define PG8_SA(b, h) (((b) * 2 + (h)) * HTB)
#define PG8_SB(b, h) ((4 + (b) * 2 + (h)) * HTB)
#define PG8_STAGE(bufoff, gbase, voff) do { _Pragma("unroll") for (int _i = 0; _i < 2; ++_i) \
        __builtin_amdgcn_global_load_lds((const unsigned*)((const char*)(gbase) + (voff)[_i]), (PG8_LAS unsigned*)(lds + (bufoff) + ldsw + _i * 8192), 16, 0, 0); } while (0)
#define PG8_LDA(dst, b, h) do { _Pragma("unroll") for (int m = 0; m < 4; ++m) _Pragma("unroll") for (int k = 0; k < 2; ++k) dst[m][k] = *(const PG8_LAS bf16x8*)(lds + PG8_SA(b, h) + aoff + m * 2048 + k * 1024); } while (0)
#define PG8_LDB(dst, b, h) do { _Pragma("unroll") for (int n = 0; n < 2; ++n) _Pragma("unroll") for (int k = 0; k < 2; ++k) dst[n][k] = *(const PG8_LAS bf16x8*)(lds + PG8_SB(b, h) + boff + n * 2048 + k * 1024); } while (0)
#define PG8_MMA(ai, bj, At, Bt) do { __builtin_amdgcn_s_setprio(1); _Pragma("unroll") for (int m = 0; m < 4; ++m) _Pragma("unroll") for (int n = 0; n < 2; ++n) _Pragma("unroll") for (int k = 0; k < 2; ++k) \
        acc[ai][bj][m][n] = __builtin_amdgcn_mfma_f32_16x16x32_bf16(Bt[n][k], At[m][k], acc[ai][bj][m][n], 0, 0, 0); __builtin_amdgcn_s_setprio(0); } while (0)
#define PG8_WAIT_V(n) asm volatile("s_waitcnt vmcnt(" #n ")" ::: "memory")
#define PG8_WAIT_L(n) asm volatile("s_waitcnt lgkmcnt(" #n ")" ::: "memory")
#define PG8_BAR __builtin_amdgcn_s_barrier()
#define PG8_SCHED __builtin_amdgcn_sched_barrier(0)
    Unit cur, nxt; int ui = 0;
    if (!S.next(0, cur)) return;
    f32x4 acc[2][2][4][2];
#pragma unroll
    for (int a = 0; a < 2; ++a)
#pragma unroll
        for (int b = 0; b < 2; ++b)
#pragma unroll
            for (int m = 0; m < 4; ++m)
#pragma unroll
                for (int n = 0; n < 2; ++n) acc[a][b][m][n] = (f32x4){0.f, 0.f, 0.f, 0.f};
    bf16x8 At[4][2], B0[2][2], B1[2][2];
    const char* cA = (const char*)g.A + (size_t)cur.pm * tstep; const char* cB = (const char*)g.Bt + (size_t)cur.pn * tstep;
    S.a_ready(cur);
    if constexpr (SP2) {
        PG8_STAGE(PG8_SB(0, 0), cB, voffB); PG8_STAGE(PG8_SB(0, 1), cB + hstep, voffB); PG8_STAGE(PG8_SA(0, 0), cA, voffA); PG8_STAGE(PG8_SA(0, 1), cA + hstep, voffA);
        if (wr == 1) PG8_BAR;
        PG8_WAIT_V(2); PG8_BAR;
        PG8_STAGE(PG8_SB(1, 0), cB + kstep, voffB); PG8_STAGE(PG8_SA(1, 0), cA + kstep, voffA); PG8_STAGE(PG8_SB(1, 1), cB + hstep + kstep, voffB);
        PG8_WAIT_V(6); PG8_BAR;
    } else {
        PG8_STAGE(PG8_SB(0, 0), cB, voffB); PG8_STAGE(PG8_SA(0, 0), cA, voffA); PG8_STAGE(PG8_SB(0, 1), cB + hstep, voffB); PG8_STAGE(PG8_SA(0, 1), cA + hstep, voffA);
        if (wr == 1) PG8_BAR;
        PG8_WAIT_V(4); PG8_BAR;
        PG8_STAGE(PG8_SB(1, 0), cB + kstep, voffB); PG8_STAGE(PG8_SA(1, 0), cA + kstep, voffA); PG8_STAGE(PG8_SB(1, 1), cB + hstep + kstep, voffB);
        PG8_WAIT_V(6); PG8_BAR;
    }
    for (;;) {
        const bool has_next = S.next(ui + 1, nxt);
        const char* nA = has_next ? (const char*)g.A + (size_t)nxt.pm * tstep : cA; const char* nB = has_next ? (const char*)g.Bt + (size_t)nxt.pn * tstep : cB;
        for (int t = 0; t < nt; t += 2) {
            const bool last = (t == nt - 2);
            const char* a1 = cA + (size_t)(t + 1) * kstep;
            const char* a2 = last ? nA : cA + (size_t)(t + 2) * kstep; const char* b2 = last ? nB : cB + (size_t)(t + 2) * kstep;
            const char* a3 = a2 + kstep; const char* b3 = b2 + kstep;
            if (last && has_next) S.a_ready(nxt);
            if constexpr (SP2) {
            PG8_LDB(B0, 0, 0); PG8_LDB(B1, 0, 1); PG8_SCHED; PG8_LDA(At, 0, 0); PG8_STAGE(PG8_SA(1, 1), a1 + hstep, voffA);
            PG8_WAIT_V(8); PG8_WAIT_L(0); PG8_BAR; PG8_MMA(0, 0, At, B0); PG8_MMA(0, 1, At, B1); PG8_BAR; PG8_SCHED;
            PG8_LDA(At, 0, 1); PG8_STAGE(PG8_SB(0, 0), b2, voffB); PG8_STAGE(PG8_SB(0, 1), b2 + hstep, voffB); PG8_STAGE(PG8_SA(0, 0), a2, voffA);
            PG8_WAIT_V(8); PG8_WAIT_L(0); PG8_BAR; PG8_MMA(1, 0, At, B0); PG8_MMA(1, 1, At, B1); PG8_BAR; PG8_SCHED;
            PG8_LDB(B0, 1, 0); PG8_LDB(B1, 1, 1); PG8_SCHED; PG8_LDA(At, 1, 0); PG8_STAGE(PG8_SA(0, 1), a2 + hstep, voffA);
            PG8_WAIT_V(8); PG8_WAIT_L(0); PG8_BAR; PG8_MMA(0, 0, At, B0); PG8_MMA(0, 1, At, B1); PG8_BAR; PG8_SCHED;
            PG8_LDA(At, 1, 1); PG8_STAGE(PG8_SB(1, 0), b3, voffB); PG8_STAGE(PG8_SB(1, 1), b3 + hstep, voffB); PG8_STAGE(PG8_SA(1, 0), a3, voffA);
            PG8_WAIT_V(8); PG8_WAIT_L(0); PG8_BAR; PG8_MMA(1, 0, At, B0); PG8_MMA(1, 1, At, B1); PG8_BAR; PG8_SCHED;
            } else {
            PG8_LDB(B0, 0, 0); PG8_SCHED; PG8_LDA(At, 0, 0); PG8_STAGE(PG8_SA(1, 1), a1 + hstep, voffA);
            PG8_WAIT_L(8); PG8_BAR; PG8_WAIT_L(0); PG8_MMA(0, 0, At, B0); PG8_BAR; PG8_SCHED;
            PG8_LDB(B1, 0, 1); PG8_STAGE(PG8_SB(0, 0), b2, voffB);
            PG8_BAR; PG8_WAIT_L(0); PG8_MMA(0, 1, At, B1); PG8_BAR;
            PG8_LDA(At, 0, 1); PG8_STAGE(PG8_SA(0, 0), a2, voffA);
            PG8_BAR; PG8_WAIT_L(0); PG8_MMA(1, 0, At, B0); PG8_BAR; PG8_SCHED;
            PG8_STAGE(PG8_SB(0, 1), b2 + hstep, voffB);
            PG8_WAIT_V(6); PG8_BAR; PG8_MMA(1, 1, At, B1); PG8_BAR;
            PG8_LDB(B0, 1, 0); PG8_SCHED; PG8_LDA(At, 1, 0); PG8_STAGE(PG8_SA(0, 1), a2 + hstep, voffA);
            PG8_WAIT_L(8); PG8_BAR; PG8_WAIT_L(0); PG8_MMA(0, 0, At, B0); PG8_BAR; PG8_SCHED;
            PG8_LDB(B1, 1, 1); PG8_STAGE(PG8_SB(1, 0), b3, voffB);
            PG8_BAR; PG8_WAIT_L(0); PG8_MMA(0, 1, At, B1); PG8_BAR;
            PG8_LDA(At, 1, 1); PG8_STAGE(PG8_SA(1, 0), a3, voffA);
            PG8_BAR; PG8_WAIT_L(0); PG8_MMA(1, 0, At, B0); PG8_BAR; PG8_SCHED;
            PG8_STAGE(PG8_SB(1, 1), b3 + hstep, voffB);
            PG8_WAIT_V(6); PG8_BAR; PG8_MMA(1, 1, At, B1); PG8_BAR;
            }
        }
        if constexpr (ALIGN_EPI) { if (wr == 0) PG8_BAR; }
        if constexpr (!Epi::AFTER_DRAIN) { E(acc, cur, wr, wc, fr, fq); S.done(cur); }
        if (!has_next) break;
#pragma unroll
        for (int a = 0; a < 2; ++a)
#pragma unroll
            for (int b = 0; b < 2; ++b)
#pragma unroll
                for (int m = 0; m < 4; ++m)
#pragma unroll
                    for (int n = 0; n < 2; ++n) acc[a][b][m][n] = (f32x4){0.f, 0.f, 0.f, 0.f};
        cur = nxt; cA = nA; cB = nB; ++ui;
        if constexpr (ALIGN_EPI) { if (wr == 1) PG8_BAR; }
    }
    PG8_WAIT_V(0);
    if constexpr (!ALIGN_EPI) { if (wr == 0) PG8_BAR; }
    PG8_BAR;
    if constexpr (Epi::AFTER_DRAIN) { E.fused(acc, cur, wr, wc, fr, fq, lds, wid, lane); S.done(cur); }
#undef PG8_SA
#undef PG8_SB
#undef PG8_STAGE
#undef PG8_LDA
#undef PG8_LDB
#undef PG8_MMA
#undef PG8_WAIT_V
#undef PG8_WAIT_L
#undef PG8_BAR
#undef PG8_SCHED
}
}

#define LAS __attribute__((address_space(3)))
typedef unsigned short bf16_t;
typedef short bf16x8 __attribute__((ext_vector_type(8)));
typedef short s16x4 __attribute__((ext_vector_type(4)));
typedef float f32x4 __attribute__((ext_vector_type(4)));
typedef float f32x16 __attribute__((ext_vector_type(16)));
typedef unsigned u32x4 __attribute__((ext_vector_type(4)));
typedef unsigned u32x2 __attribute__((ext_vector_type(2)));

constexpr int DM = 1024, NBATCH = 8, SEQ = 4096, TOK = NBATCH * SEQ, FFN = 2816, FFN2 = 5632;
constexpr int DSA_N = 2760, PROJ_LD = 2816;
constexpr int PJ_LAT = 2048, PJ_QI = 2176, PJ_KI = 2688, PJ_WI = 2752;
constexpr float RMS_EPS = 1e-6f, LOG2E = 1.4426950408889634f;
constexpr int NTHR = 512, NWAVE = 8;
constexpr int LDS_PHASE_BYTES = 156160, LDS_BYTES = LDS_PHASE_BYTES + 64;

constexpr size_t MiB = 1u << 20;
constexpr size_t WS_MOD = 0;
constexpr size_t WS_BIASD = 512 * 1024;
constexpr size_t WS_RK = 1 * MiB;
constexpr size_t WS_BAR = 1536 * 1024;
constexpr size_t WS_WQKV = 2 * MiB;
constexpr size_t WS_WSBO = 8 * MiB;
constexpr size_t WS_WDIN = 10 * MiB;
constexpr size_t WS_WDO = 16 * MiB;
constexpr size_t WS_WUP0 = 20 * MiB, WS_WUP1 = 31 * MiB;
constexpr size_t WS_WDN0 = 42 * MiB, WS_WDN1 = 48 * MiB;
constexpr size_t WS_HF = 54 * MiB, WS_HL = 76 * MiB;
constexpr size_t WS_H = 100 * MiB;
constexpr size_t WS_A = 164 * MiB;
constexpr size_t WS_B = 356 * MiB;
constexpr size_t WS_SEL = 484 * MiB;
constexpr size_t WS_END = 500 * MiB;

struct Params { const float* in[18]; float* out; unsigned char* ws; };

__device__ __forceinline__ unsigned f2bf(float f) { unsigned u = __builtin_bit_cast(unsigned, f); return (u + 0x7fffu + ((u >> 16) & 1u)) >> 16; }
__device__ __forceinline__ unsigned pk2(float lo, float hi) { return f2bf(lo) | (f2bf(hi) << 16); }
__device__ __forceinline__ float bflo(unsigned w) { return __builtin_bit_cast(float, w << 16); }
__device__ __forceinline__ float bfhi(unsigned w) { return __builtin_bit_cast(float, w & 0xffff0000u); }
__device__ __forceinline__ float wave_sum(float v) {
#pragma unroll
    for (int o = 1; o < 64; o <<= 1) v += __shfl_xor(v, o);
    return v;
}
#define LDS_WAIT() asm volatile("s_waitcnt lgkmcnt(0)" ::: "memory")

struct EpiBf16 {
    static constexpr bool PERM = true, AFTER_DRAIN = false;
    bf16_t* O; int ldc; int split_cols; size_t split_stride; float scale0;
    __device__ __forceinline__ void operator()(const f32x4 (&acc)[2][2][4][2], const pg8::Unit& u, int wr, int wc, int fr, int fq) const {
        const int row0 = u.pm * 256 + wr * 64 + fr; int colt = u.pn * 256; bf16_t* base = O;
        float sc = 1.f; if (split_cols) { const int t = colt / split_cols; base += (size_t)t * split_stride; colt -= t * split_cols; if (t == 0) sc = scale0; }
        const int col0 = colt + wc * 32 + 8 * fq;
#pragma unroll
        for (int ai = 0; ai < 2; ++ai)
#pragma unroll
            for (int m = 0; m < 4; ++m) { bf16_t* rowp = base + (size_t)(row0 + ai * 128 + m * 16) * ldc + col0;
#pragma unroll
                for (int bj = 0; bj < 2; ++bj) { const f32x4 v0 = acc[ai][bj][m][0] * sc, v1 = acc[ai][bj][m][1] * sc;
                    u32x4 w; w.x = pg8::cvt_pk_bf16(v0[0], v0[1]); w.y = pg8::cvt_pk_bf16(v0[2], v0[3]); w.z = pg8::cvt_pk_bf16(v1[0], v1[1]); w.w = pg8::cvt_pk_bf16(v1[2], v1[3]);
                    *(u32x4*)(rowp + bj * 128) = w; } }
    }
};
template <int CTRL> __device__ __forceinline__ float dpp_ror(float v) { return __builtin_bit_cast(float, __builtin_amdgcn_update_dpp(0, __builtin_bit_cast(int, v), CTRL, 0xf, 0xf, false)); }
struct EpiResid {
    static constexpr bool PERM = false, AFTER_DRAIN = false;
    const float* resid; float* out; const float* gate;
    __device__ __forceinline__ void operator()(const f32x4 (&acc)[2][2][4][2], const pg8::Unit& u, int wr, int wc, int fr, int fq) const {
        const float* g = gate + (size_t)(u.pm >> 4) * 6144;
        const int col0 = u.pn * 256 + wc * 32 + 4 * fq;
        f32x4 gv[2][2];
#pragma unroll
        for (int bj = 0; bj < 2; ++bj)
#pragma unroll
            for (int n = 0; n < 2; ++n) gv[bj][n] = *(const f32x4*)(g + col0 + bj * 128 + n * 16);
        const bool lo8 = fr < 8;
        const int rsel = fr & 7, csel = lo8 ? 0 : 16;
#pragma unroll
        for (int ai = 0; ai < 2; ++ai)
#pragma unroll
            for (int m = 0; m < 4; ++m) { const size_t off = (size_t)(u.pm * 256 + ai * 128 + wr * 64 + m * 16 + fr) * DM + col0;
                const size_t offs = (size_t)(u.pm * 256 + ai * 128 + wr * 64 + m * 16 + rsel) * DM + col0 + csel;
#pragma unroll
                for (int bj = 0; bj < 2; ++bj) {
                    const f32x4 a = *(const f32x4*)(resid + off + bj * 128) + gv[bj][0] * acc[ai][bj][m][0];
                    const f32x4 b = *(const f32x4*)(resid + off + bj * 128 + 16) + gv[bj][1] * acc[ai][bj][m][1];
                    f32x4 y;
#pragma unroll
                    for (int j = 0; j < 4; ++j) y[j] = dpp_ror<0x128>(lo8 ? b[j] : a[j]);
                    f32x4 s1, s2;
#pragma unroll
                    for (int j = 0; j < 4; ++j) { s1[j] = lo8 ? a[j] : y[j]; s2[j] = lo8 ? y[j] : b[j]; }
                    *(f32x4*)(out + offs + bj * 128) = s1;
                    *(f32x4*)(out + offs + (size_t)8 * DM + bj * 128) = s2;
                }
            }
    }
};
__device__ __forceinline__ float silu_f(float g) { return g * __builtin_amdgcn_rcpf(1.f + __builtin_amdgcn_exp2f(-g * LOG2E)); }
struct EpiConvGate {
    static constexpr bool PERM = true, AFTER_DRAIN = false;
    bf16_t* act; float* hf; float* hl; const float* cw; const float* cb;
    __device__ __forceinline__ void operator()(const f32x4 (&acc)[2][2][4][2], const pg8::Unit& u, int wr, int wc, int fr, int fq) const {
#pragma unroll
        for (int n = 0; n < 2; ++n) {
            const int f0 = u.pn * 128 + wc * 32 + 8 * fq + 4 * n;
            f32x4 w[2][3], bb[2];
#pragma unroll
            for (int bj = 0; bj < 2; ++bj) { const int col = bj * FFN + f0; bb[bj] = *(const f32x4*)(cb + col);
#pragma unroll
                for (int tp = 0; tp < 3; ++tp) w[bj][tp] = *(const f32x4*)(cw + tp * FFN2 + col); }
#pragma unroll
            for (int ai = 0; ai < 2; ++ai) {
                const int wb = (u.pm * 2 + ai) * 2 + wr;
                f32x4 p1[2], p2[2];
                p1[0] = p1[1] = p2[0] = p2[1] = (f32x4){0.f, 0.f, 0.f, 0.f};
#pragma unroll
                for (int m = 0; m < 4; ++m) {
                    f32x4 y[2];
#pragma unroll
                    for (int bj = 0; bj < 2; ++bj) {
                        const f32x4 cur = acc[ai][bj][m][n]; f32x4 r1, r2;
#pragma unroll
                        for (int j = 0; j < 4; ++j) { r1[j] = dpp_ror<0x121>(cur[j]); r2[j] = dpp_ror<0x122>(cur[j]); }
                        const f32x4 s1 = (fr >= 1) ? r1 : p1[bj], s2 = (fr >= 2) ? r2 : p2[bj];
                        y[bj] = bb[bj] + w[bj][0] * s2 + w[bj][1] * s1 + w[bj][2] * cur;
                        p1[bj] = r1; p2[bj] = r2;
                        if (m == 0 && fr < 2) *(f32x4*)(hf + (size_t)(wb * 2 + fr) * FFN2 + bj * FFN + f0) = cur;
                        if (m == 3 && fr >= 14) *(f32x4*)(hl + (size_t)(wb * 2 + fr - 14) * FFN2 + bj * FFN + f0) = cur;
                    }
                    u32x2 o; o.x = pg8::cvt_pk_bf16(silu_f(y[0][0]) * y[1][0], silu_f(y[0][1]) * y[1][1]); o.y = pg8::cvt_pk_bf16(silu_f(y[0][2]) * y[1][2], silu_f(y[0][3]) * y[1][3]);
                    *(u32x2*)(act + (size_t)(wb * 64 + m * 16 + fr) * FFN + f0) = o;
                }
            }
        }
    }
};

__device__ __forceinline__ void transpose_item(const float* W, int K, int N, bf16_t* WT, int dst_row0, LAS float* scr, int k0, int n0, int lane) {
    const int c4 = (lane & 7) * 4, n = n0 + c4;
#pragma unroll
    for (int i = 0; i < 8; ++i) { const int kk = 8 * i + (lane >> 3);
        const f32x4 v = (n < N) ? *(const f32x4*)(W + (size_t)(k0 + kk) * N + n) : (f32x4){0.f, 0.f, 0.f, 0.f};
        scr[kk * 33 + c4] = v[0]; scr[kk * 33 + c4 + 1] = v[1]; scr[kk * 33 + c4 + 2] = v[2]; scr[kk * 33 + c4 + 3] = v[3]; }
    LDS_WAIT();
    const int c = lane & 7;
#pragma unroll
    for (int j = 0; j < 4; ++j) { const int nn = (lane >> 3) + 8 * j; const LAS float* s = scr + (8 * c) * 33 + nn;
        u32x4 o; o.x = pk2(s[0 * 33], s[1 * 33]); o.y = pk2(s[2 * 33], s[3 * 33]); o.z = pk2(s[4 * 33], s[5 * 33]); o.w = pk2(s[6 * 33], s[7 * 33]);
        *(u32x4*)(WT + (size_t)(dst_row0 + nn) * K + k0 + 8 * c) = o; }
    LDS_WAIT();
}
__device__ __forceinline__ int t5_bucket(int n) {
    if (n < 16) return n;
    return 16 + (n >= 19) + (n >= 21) + (n >= 24) + (n >= 27) + (n >= 31) + (n >= 35) + (n >= 40) + (n >= 46) + (n >= 52) + (n >= 59) + (n >= 67) + (n >= 77) + (n >= 87) + (n >= 99) + (n >= 113);
}
__device__ __forceinline__ void p0_prologue(const Params& p, LAS unsigned char* lds) {
    const int tid = fresh_tid(), lane = tid & 63, wave = tid >> 6, G = gridDim.x;
    const int gw = blockIdx.x * NWAVE + wave, NGW = G * NWAVE;
    unsigned char* ws = p.ws;
    {
        LAS float* condS = (LAS float*)lds;
        LAS float* red = (LAS float*)(lds + 32768);
        if ((int)blockIdx.x < 192) {
            for (int e = tid; e < NBATCH * DM; e += NTHR) { const float c = p.in[1][e]; condS[e] = c / (1.f + __expf(-c)); }
            __syncthreads();
        }
        for (int item = blockIdx.x; item < 192; item += G) {
            const int l = item / 96, col0 = (item % 96) * 64, col = tid & 63, kg = tid >> 6;
            const float* W = p.in[2] + (size_t)l * DM * 6144 + col0 + col;
            float a[8];
#pragma unroll
            for (int b = 0; b < 8; ++b) a[b] = 0.f;
#pragma unroll 8
            for (int k = kg * 128; k < kg * 128 + 128; ++k) { const float w = W[(size_t)k * 6144];
#pragma unroll
                for (int b = 0; b < 8; ++b) a[b] += condS[b * DM + k] * w; }
#pragma unroll
            for (int b = 0; b < 8; ++b) red[(kg * 8 + b) * 64 + col] = a[b];
            __syncthreads();
            { const int b = tid >> 6; float s = 0.f;
#pragma unroll
              for (int g = 0; g < 8; ++g) s += red[(g * 8 + b) * 64 + col];
              ((float*)(ws + WS_MOD))[(size_t)(l * 8 + b) * 6144 + col0 + col] = s + p.in[3][l * 6144 + col0 + col]; }
            __syncthreads();
        }
        __syncthreads();
    }
    { const int g = blockIdx.x * NTHR + tid; if (g < 2048) ((float*)(ws + WS_BIASD))[g] = p.in[13][t5_bucket(g >> 4) * 16 + (g & 15)] * LOG2E; }
}
__device__ __forceinline__ void p0_weights(const Params& p, LAS unsigned char* lds) {
    const int tid = fresh_tid(), lane = tid & 63, wave = tid >> 6, G = gridDim.x;
    const int gw = blockIdx.x * NWAVE + wave, NGW = G * NWAVE;
    unsigned char* ws = p.ws;
    {
        LAS float* scr = (LAS float*)(lds + wave * 16384);
        for (int it = gw; it < 11904; it += NGW) {
            const float* W; int K, N, nblk, mode = 0, r = it; bf16_t* WT;
            if (r < 1536) { W = p.in[6]; K = 1024; N = 3072; nblk = 96; WT = (bf16_t*)(ws + WS_WQKV); }
            else if ((r -= 1536) < 512) { W = p.in[7]; K = 1024; N = 1024; nblk = 32; WT = (bf16_t*)(ws + WS_WSBO); }
            else if ((r -= 512) < 1408) { W = p.in[8]; K = 1024; N = DSA_N; nblk = 88; WT = (bf16_t*)(ws + WS_WDIN); }
            else if ((r -= 1408) < 2816) { W = p.in[14]; K = 1024; N = FFN2; nblk = 176; WT = (bf16_t*)(ws + WS_WUP0); mode = 1; }
            else if ((r -= 2816) < 2816) { W = p.in[14] + (size_t)DM * FFN2; K = 1024; N = FFN2; nblk = 176; WT = (bf16_t*)(ws + WS_WUP1); mode = 1; }
            else if ((r -= 2816) < 1408) { W = p.in[17]; K = FFN; N = 1024; nblk = 32; WT = (bf16_t*)(ws + WS_WDN0); }
            else { r -= 1408; W = p.in[17] + (size_t)FFN * DM; K = FFN; N = 1024; nblk = 32; WT = (bf16_t*)(ws + WS_WDN1); }
            const int kb = r / nblk, nb = r % nblk, n0 = nb * 32;
            int dst = n0;
            if (mode == 1) { const int bj = n0 / FFN, f = n0 % FFN; dst = 256 * (f / 128) + 128 * bj + (f % 128); }
            transpose_item(W, K, N, WT, dst, scr, kb * 64, n0, lane);
        }
    }
    for (int it = gw; it < 4096; it += NGW) {
        const int n0 = (it >> 5) * 8, k = (it & 31) * 64 + lane, h = k >> 7;
        const float* uv = p.in[11] + (size_t)k * 64;
        const float* wo = p.in[12] + (size_t)(h * 64) * DM + n0;
        float a[8];
#pragma unroll
        for (int i = 0; i < 8; ++i) a[i] = 0.f;
#pragma unroll 4
        for (int v4 = 0; v4 < 16; ++v4) { const f32x4 x = *(const f32x4*)(uv + v4 * 4);
#pragma unroll
            for (int j = 0; j < 4; ++j) { const f32x4 w0 = *(const f32x4*)(wo + (size_t)(v4 * 4 + j) * DM), w1 = *(const f32x4*)(wo + (size_t)(v4 * 4 + j) * DM + 4);
                a[0] += x[j] * w0[0]; a[1] += x[j] * w0[1]; a[2] += x[j] * w0[2]; a[3] += x[j] * w0[3];
                a[4] += x[j] * w1[0]; a[5] += x[j] * w1[1]; a[6] += x[j] * w1[2]; a[7] += x[j] * w1[3]; } }
        bf16_t* WT = (bf16_t*)(ws + WS_WDO);
#pragma unroll
        for (int i = 0; i < 8; ++i) WT[(size_t)(n0 + i) * 2048 + k] = (bf16_t)f2bf(a[i]);
    }
}

__device__ __forceinline__ void norm_phase(const float* src, const float* gain, const float* mod_l, int sh_off, int sc_off, bf16_t* dst) {
    const int tid = fresh_tid(), lane = tid & 63, gw = blockIdx.x * NWAVE + (tid >> 6), NGW = gridDim.x * NWAVE;
    const int rpw = (TOK + NGW - 1) / NGW, r0 = gw * rpw, r1 = (r0 + rpw < TOK) ? r0 + rpw : TOK;
    f32x4 cs[4], sh[4]; int cur_b = -1;
    for (int row = r0; row < r1; ++row) {
        const int b = row >> 12;
        if (b != cur_b) { const float* mb = mod_l + (size_t)b * 6144;
#pragma unroll
            for (int j = 0; j < 4; ++j) { const int col = 4 * lane + 256 * j;
                cs[j] = *(const f32x4*)(gain + col) * (*(const f32x4*)(mb + sc_off + col) + 1.f); sh[j] = *(const f32x4*)(mb + sh_off + col); }
            cur_b = b; }
        const f32x4* xr = (const f32x4*)(src + (size_t)row * DM) + lane;
        f32x4 v[4]; float ss = 0.f;
#pragma unroll
        for (int j = 0; j < 4; ++j) { v[j] = xr[64 * j]; ss += (v[j].x * v[j].x + v[j].y * v[j].y) + (v[j].z * v[j].z + v[j].w * v[j].w); }
        const float r = rsqrtf(wave_sum(ss) * (1.f / DM) + RMS_EPS);
        u32x2* o8 = (u32x2*)(dst + (size_t)row * DM) + lane;
#pragma unroll
        for (int j = 0; j < 4; ++j) { const f32x4 y = v[j] * r * cs[j] + sh[j];
            u32x2 o; o.x = pk2(y[0], y[1]); o.y = pk2(y[2], y[3]); o8[64 * j] = o; }
    }
}

__device__ __forceinline__ void fixup_phase(const float* hf, const float* hl, const float* cw, const float* cb, bf16_t* act) {
    const int gt = blockIdx.x * NTHR + fresh_tid(), NT = gridDim.x * NTHR;
    const f32x4 zero4 = (f32x4){0.f, 0.f, 0.f, 0.f};
    for (int e = gt; e < 512 * 2 * (FFN / 4); e += NT) {
        const int f = 4 * (e % (FFN / 4)), j = (e / (FFN / 4)) & 1, wb = e / (2 * (FFN / 4));
        const bool first = (wb & 63) == 0;
        f32x4 y[2];
#pragma unroll
        for (int part = 0; part < 2; ++part) {
            const int col = part * FFN + f;
            const f32x4 u0 = *(const f32x4*)(hf + (size_t)(wb * 2 + j) * FFN2 + col);
            const f32x4 lm1 = first ? zero4 : *(const f32x4*)(hl + (size_t)((wb - 1) * 2 + 1) * FFN2 + col);
            const f32x4 lm2 = first ? zero4 : *(const f32x4*)(hl + (size_t)((wb - 1) * 2 + 0) * FFN2 + col);
            const f32x4 u1 = j ? *(const f32x4*)(hf + (size_t)(wb * 2) * FFN2 + col) : lm1;
            const f32x4 u2 = j ? lm1 : lm2;
            y[part] = *(const f32x4*)(cb + col) + *(const f32x4*)(cw + col) * u2 + *(const f32x4*)(cw + FFN2 + col) * u1 + *(const f32x4*)(cw + 2 * FFN2 + col) * u0;
        }
        u32x2 o; o.x = pk2(silu_f(y[0][0]) * y[1][0], silu_f(y[0][1]) * y[1][1]); o.y = pk2(silu_f(y[0][2]) * y[1][2], silu_f(y[0][3]) * y[1][3]);
        *(u32x2*)(act + (size_t)(wb * 64 + j) * FFN + f) = o;
    }
}

__device__ __forceinline__ int crow(int r, int hi) { return (r & 3) + 8 * (r >> 2) + 4 * hi; }
__device__ __forceinline__ float other_half(float x) { const unsigned u = __builtin_bit_cast(unsigned, x); auto rr = __builtin_amdgcn_permlane32_swap(u, u, false, false);
    return __builtin_bit_cast(float, (unsigned)(rr[0] ^ rr[1] ^ u)); }
__device__ __forceinline__ void sb_qk(const LAS unsigned char* tb, const bf16x8 (&qr)[4], f32x16& p0, f32x16& p1, unsigned krd) {
    constexpr int KPITCH = 144;
    p0 = f32x16{}; p1 = f32x16{};
#pragma unroll
    for (int d0 = 0; d0 < 4; ++d0) {
        const bf16x8 a0 = *(const LAS bf16x8*)(tb + krd + d0 * 32);
        const bf16x8 a1 = *(const LAS bf16x8*)(tb + krd + 32 * KPITCH + d0 * 32);
        p0 = __builtin_amdgcn_mfma_f32_32x32x16_bf16(a0, qr[d0], p0, 0, 0, 0);
        p1 = __builtin_amdgcn_mfma_f32_32x32x16_bf16(a1, qr[d0], p1, 0, 0, 0);
    }
}
template <bool BAND> __device__ __forceinline__ void sb_sigma(f32x16& p0, f32x16& p1, int j, int t, int hi) {
#pragma unroll
    for (int r = 0; r < 16; ++r) {
        p0[r] = __builtin_amdgcn_rcpf(1.f + __builtin_amdgcn_exp2f(-p0[r]));
        p1[r] = __builtin_amdgcn_rcpf(1.f + __builtin_amdgcn_exp2f(-p1[r]));
    }
    if (BAND) {
#pragma unroll
        for (int r = 0; r < 16; ++r) { const int kv = 64 * j + crow(r, hi); if (kv >= t) p0[r] = 0.f; if (kv + 32 >= t) p1[r] = 0.f; }
    }
}
__device__ __forceinline__ void sb_local(f32x16& p, float (&G)[4]) {
#pragma unroll
    for (int g = 0; g < 4; ++g) {
        const float k0 = 1.f - p[4 * g], k1 = 1.f - p[4 * g + 1], k2 = 1.f - p[4 * g + 2], k3 = 1.f - p[4 * g + 3];
        const float s2 = k3, s1 = k3 * k2, s0 = s1 * k1;
        p[4 * g + 2] *= s2; p[4 * g + 1] *= s1; p[4 * g] *= s0; G[g] = s0 * k0;
    }
}
__device__ __forceinline__ void sb_chain(const float (&G1)[4], const float (&G0)[4], float& acc, float (&mine1)[4], float (&mine0)[4], int r32, int hi) {
#pragma unroll
    for (int g = 3; g >= 0; --g) {
        const float gl = __shfl(G1[g], r32), gh = __shfl(G1[g], r32 + 32);
        const float m1 = acc; acc *= gh; const float m0 = acc; acc *= gl; mine1[g] = hi ? m1 : m0;
    }
#pragma unroll
    for (int g = 3; g >= 0; --g) {
        const float gl = __shfl(G0[g], r32), gh = __shfl(G0[g], r32 + 32);
        const float m1 = acc; acc *= gh; const float m0 = acc; acc *= gl; mine0[g] = hi ? m1 : m0;
    }
}
__device__ __forceinline__ void sb_pv(const LAS unsigned char* tb, const f32x16& p0, const f32x16& p1, const float (&mine0)[4], const float (&mine1)[4], f32x16 (&o)[2], unsigned vrd) {
#pragma unroll
    for (int X = 1; X >= 0; --X)
#pragma unroll
        for (int s = 0; s < 2; ++s) {
            u32x4 pw;
#define AV(i) (X == 0 ? p0[8 * s + (i)] * mine0[(8 * s + (i)) >> 2] : p1[8 * s + (i)] * mine1[(8 * s + (i)) >> 2])
            pw.x = pg8::cvt_pk_bf16(AV(0), AV(1)); pw.y = pg8::cvt_pk_bf16(AV(2), AV(3)); pw.z = pg8::cvt_pk_bf16(AV(4), AV(5)); pw.w = pg8::cvt_pk_bf16(AV(6), AV(7));
#undef AV
            const bf16x8 pf = __builtin_bit_cast(bf16x8, pw);
#pragma unroll
            for (int c = 0; c < 2; ++c) {
                const LAS unsigned char* vp = tb + vrd + ((8 * X + 4 * s) * 4 + 2 * c) * 128;
                const s16x4 lo = __builtin_bit_cast(s16x4, __builtin_amdgcn_ds_read_tr16_b64_v4i16((LAS s16x4*)(vp)));
                const s16x4 hh = __builtin_bit_cast(s16x4, __builtin_amdgcn_ds_read_tr16_b64_v4i16((LAS s16x4*)(vp + 2 * 4 * 128)));
                const bf16x8 vf = (bf16x8){lo[0], lo[1], lo[2], lo[3], hh[0], hh[1], hh[2], hh[3]};
                o[c] = __builtin_amdgcn_mfma_f32_32x32x16_bf16(vf, pf, o[c], 0, 0, 0);
            }
        }
}
__device__ __forceinline__ void sb_tile(const LAS unsigned char* tb, int j, const bf16x8 (&qr)[4], f32x16 (&o)[2], float& Rp, int t, int tq0, int r32, int hi, unsigned krd, unsigned vrd) {
    if (!(64 * j < tq0 + 31)) return;
    if (__all(Rp == 0.f)) return;
    f32x16 p0, p1; float G0[4], G1[4], mine0[4], mine1[4];
    sb_qk(tb, qr, p0, p1, krd);
    if (64 * j + 63 >= tq0) sb_sigma<true>(p0, p1, j, t, hi); else sb_sigma<false>(p0, p1, j, t, hi);
    sb_local(p0, G0); sb_local(p1, G1);
    sb_chain(G1, G0, Rp, mine1, mine0, r32, hi);
    sb_pv(tb, p0, p1, mine0, mine1, o, vrd);
}
__device__ __forceinline__ void sb_tile2(const LAS unsigned char* tbA, const LAS unsigned char* tbB, const bf16x8 (&qr)[4], f32x16 (&o)[2], float& Rp, int r32, int hi, unsigned krd, unsigned vrd) {
    if (__all(Rp == 0.f)) return;
    f32x16 a0, a1, b0, b1; float GA0[4], GA1[4], GB0[4], GB1[4], mA0[4], mA1[4], mB0[4], mB1[4];
    sb_qk(tbA, qr, a0, a1, krd);
    sb_qk(tbB, qr, b0, b1, krd);
    sb_sigma<false>(a0, a1, 0, 0, hi);
    sb_local(a0, GA0); sb_local(a1, GA1);
    sb_chain(GA1, GA0, Rp, mA1, mA0, r32, hi);
    sb_sigma<false>(b0, b1, 0, 0, hi);
    sb_pv(tbA, a0, a1, mA0, mA1, o, vrd);
    sb_local(b0, GB0); sb_local(b1, GB1);
    sb_chain(GB1, GB0, Rp, mB1, mB0, r32, hi);
    sb_pv(tbB, b0, b1, mB0, mB1, o, vrd);
}
__device__ __forceinline__ void sb_attn_phase(const bf16_t* Q, const bf16_t* K, const bf16_t* V, bf16_t* O, LAS unsigned char* lds) {
    constexpr int KPITCH = 144, KBYTES = 64 * KPITCH, BUFB = KBYTES + 8192;
    const int tid = fresh_tid(), lane = tid & 63, r32 = lane & 31, hi = lane >> 5;
    const int wid = __builtin_amdgcn_readfirstlane(tid >> 6);
    const int kv_s = tid >> 3, d8 = tid & 7;
    const unsigned kst = kv_s * KPITCH + d8 * 16;
    const unsigned vst = KBYTES + ((kv_s >> 2) * 4 + (d8 >> 1)) * 128 + (kv_s & 3) * 32 + (d8 & 1) * 16;
    const unsigned vrd = KBYTES + (hi * 4 + ((lane >> 4) & 1)) * 128 + ((lane & 15) >> 2) * 32 + (lane & 3) * 8;
    const unsigned krd = r32 * KPITCH + hi * 16;
    LAS unsigned* votes = (LAS unsigned*)(lds + 4 * BUFB);
    for (int pi = blockIdx.x; pi < 1024; pi += gridDim.x) {
#pragma unroll 1
        for (int half = 0; half < 2; ++half) {
            const int bh = pi >> 3, sidx = pi & 7, qb = half ? 15 - sidx : sidx;
            const int b = bh >> 4, h = bh & 15;
            const size_t rowbase = (size_t)b * SEQ;
            const int q0 = qb * 256, tq0 = q0 + 32 * wid, t = tq0 + r32;
            const int NP = 2 * (qb + 1);
            bf16x8 qr[4];
#pragma unroll
            for (int d0 = 0; d0 < 4; ++d0) qr[d0] = *(const bf16x8*)(Q + (rowbase + t) * DM + h * 64 + d0 * 16 + hi * 8);
            f32x16 o[2]; o[0] = f32x16{}; o[1] = f32x16{};
            float Rp = 1.f;
            const bf16_t* Kg = K + (rowbase + kv_s) * DM + h * 64 + d8 * 8;
            const bf16_t* Vg = V + (rowbase + kv_s) * DM + h * 64 + d8 * 8;
            u32x4 kreg[2], vreg[2];
#pragma unroll
            for (int s = 0; s < 2; ++s) { kreg[s] = *(const u32x4*)(Kg + (size_t)(2 * (NP - 1) + s) * 64 * DM); vreg[s] = *(const u32x4*)(Vg + (size_t)(2 * (NP - 1) + s) * 64 * DM); }
#pragma unroll
            for (int s = 0; s < 2; ++s) { *(LAS u32x4*)(lds + s * BUFB + kst) = kreg[s]; *(LAS u32x4*)(lds + s * BUFB + vst) = vreg[s]; }
            __syncthreads();
            int cur = 0;
#pragma unroll 1
            for (int jp = NP - 1; jp >= 0; --jp) {
                if (jp > 0) {
#pragma unroll
                    for (int s = 0; s < 2; ++s) { kreg[s] = *(const u32x4*)(Kg + (size_t)(2 * (jp - 1) + s) * 64 * DM); vreg[s] = *(const u32x4*)(Vg + (size_t)(2 * (jp - 1) + s) * 64 * DM); }
                }
                const LAS unsigned char* tb = lds + cur * 2 * BUFB;
                if (64 * (2 * jp + 1) + 63 < tq0) sb_tile2(tb + BUFB, tb, qr, o, Rp, r32, hi, krd, vrd);
                else { sb_tile(tb + BUFB, 2 * jp + 1, qr, o, Rp, t, tq0, r32, hi, krd, vrd); sb_tile(tb, 2 * jp, qr, o, Rp, t, tq0, r32, hi, krd, vrd); }
                if (jp > 0) {
#pragma unroll
                    for (int s = 0; s < 2; ++s) { *(LAS u32x4*)(lds + ((cur ^ 1) * 2 + s) * BUFB + kst) = kreg[s]; *(LAS u32x4*)(lds + ((cur ^ 1) * 2 + s) * BUFB + vst) = vreg[s]; }
                }
                if (lane == 0) votes[cur * 8 + wid] = __all(Rp == 0.f) ? 1u : 0u;
                __syncthreads();
                { const u32x4 v0 = *(const LAS u32x4*)(votes + cur * 8), v1 = *(const LAS u32x4*)(votes + cur * 8 + 4);
                  if ((v0.x & v0.y & v0.z & v0.w & v1.x & v1.y & v1.z & v1.w) != 0u) break; }
                cur ^= 1;
            }
            __syncthreads();
            { LAS unsigned char* stg = lds + 73728 + wid * 4352;
#pragma unroll
              for (int c = 0; c < 2; ++c)
#pragma unroll
                for (int g = 0; g < 4; ++g) { u32x2 w; w.x = pg8::cvt_pk_bf16(o[c][4 * g], o[c][4 * g + 1]); w.y = pg8::cvt_pk_bf16(o[c][4 * g + 2], o[c][4 * g + 3]);
                    *(LAS u32x2*)(stg + r32 * 136 + 64 * c + 16 * g + 8 * hi) = w; }
              LDS_WAIT();
              bf16_t* Ob = O + (rowbase + tq0) * DM + h * 64;
#pragma unroll
              for (int k = 0; k < 4; ++k) { const int pc = lane + 64 * k, rw = pc >> 3, pp = pc & 7;
                  const u32x2 v0 = *(const LAS u32x2*)(stg + rw * 136 + pp * 16), v1 = *(const LAS u32x2*)(stg + rw * 136 + pp * 16 + 8);
                  *(u32x4*)(Ob + (size_t)rw * DM + pp * 8) = (u32x4){v0.x, v0.y, v1.x, v1.y}; }
              LDS_WAIT(); }
        }
    }
}

__device__ __forceinline__ unsigned sortkey(float v) { const unsigned u = __builtin_bit_cast(unsigned, v + 0.f);
    return (u & 0x80000000u) ? ~u : (u | 0x80000000u); }
__device__ __forceinline__ void indexer_phase(const bf16_t* PJ, float* rk, unsigned short* SEL, LAS unsigned char* lds) {
    const int tid = fresh_tid(), lane = tid & 63, r32 = lane & 31, hi = lane >> 5;
    const int wid = __builtin_amdgcn_readfirstlane(tid >> 6);
    { const int gw = blockIdx.x * NWAVE + wid, NGW = gridDim.x * NWAVE;
      for (int t4 = gw; t4 < TOK / 4; t4 += NGW) { const int tok = 4 * t4 + (lane >> 4);
          const u32x4 w = *(const u32x4*)(PJ + (size_t)tok * PROJ_LD + PJ_LAT + 8 * (lane & 15));
          float ss = bflo(w.x) * bflo(w.x) + bfhi(w.x) * bfhi(w.x) + bflo(w.y) * bflo(w.y) + bfhi(w.y) * bfhi(w.y) + bflo(w.z) * bflo(w.z) + bfhi(w.z) * bfhi(w.z) + bflo(w.w) * bflo(w.w) + bfhi(w.w) * bfhi(w.w);
          ss += __shfl_xor(ss, 1); ss += __shfl_xor(ss, 2); ss += __shfl_xor(ss, 4); ss += __shfl_xor(ss, 8);
          if ((lane & 15) == 0) rk[tok] = rsqrtf(ss * (1.f / 128.f) + RMS_EPS); } }
    constexpr int AUX0 = 131072, AUXW = 3072;
    LAS unsigned* hist = (LAS unsigned*)(lds + AUX0 + wid * AUXW);
    LAS unsigned short* listA = (LAS unsigned short*)(lds + AUX0 + wid * AUXW + 2080);
    LAS float* pmm = (LAS float*)(lds + AUX0 + NWAVE * AUXW);
    for (int gl = blockIdx.x; gl < TOK / 8; gl += gridDim.x) {
        const int b = gl >> 9, jj = gl & 511, t0 = (jj < 256 ? jj : 767 - jj) * 8;
        const size_t rowbase = (size_t)b * SEQ;
        const int t = t0 + wid;
        unsigned short* selrow = SEL + (rowbase + t) * 256;
        if (t0 + 7 < 256) {
#pragma unroll
            for (int i = 0; i < 4; ++i) { const int s = lane + 64 * i; selrow[s] = (unsigned short)(s <= t ? s : 0); }
            continue;
        }
        {
            const int g = r32 >> 3, hp = (r32 >> 2) & 1, ii = r32 & 3, tq = 2 * hp + (g >> 1), head = 4 * (g & 1) + ii;
            bf16x8 af[2][4]; float wq[2][2][8];
#pragma unroll
            for (int rt = 0; rt < 2; ++rt) {
                const bf16_t* qp = PJ + (rowbase + t0 + 4 * rt + tq) * PROJ_LD + PJ_QI + head * 64 + hi * 8;
#pragma unroll
                for (int kk = 0; kk < 4; ++kk) af[rt][kk] = *(const bf16x8*)(qp + kk * 16);
#pragma unroll
                for (int qq = 0; qq < 2; ++qq) { const u32x4 w = *(const u32x4*)(PJ + (rowbase + t0 + 4 * rt + 2 * hi + qq) * PROJ_LD + PJ_WI);
                    const float sc = 0.35355339059327373f;
                    wq[rt][qq][0] = bflo(w.x) * sc; wq[rt][qq][1] = bfhi(w.x) * sc; wq[rt][qq][2] = bflo(w.y) * sc; wq[rt][qq][3] = bfhi(w.y) * sc;
                    wq[rt][qq][4] = bflo(w.z) * sc; wq[rt][qq][5] = bfhi(w.z) * sc; wq[rt][qq][6] = bflo(w.w) * sc; wq[rt][qq][7] = bfhi(w.w) * sc; }
            }
            float rmax[2][2], rmin[2][2];
#pragma unroll
            for (int rt = 0; rt < 2; ++rt)
#pragma unroll
                for (int qq = 0; qq < 2; ++qq) { rmax[rt][qq] = -INFINITY; rmin[rt][qq] = INFINITY; }
            const int nkt = (t0 + 8 + 31) >> 5;
            const bf16_t* kbase = PJ + (rowbase + r32) * PROJ_LD + PJ_KI + hi * 8;
            bf16x8 bcur[4], bnxt[4];
            int kt = wid;
#pragma unroll
            for (int kk = 0; kk < 4; ++kk) bcur[kk] = *(const bf16x8*)(kbase + (size_t)(32 * kt) * PROJ_LD + kk * 16);
#pragma unroll 1
            while (kt < nkt) {
                const int kn = kt + NWAVE;
                if (kn < nkt) {
#pragma unroll
                    for (int kk = 0; kk < 4; ++kk) bnxt[kk] = *(const bf16x8*)(kbase + (size_t)(32 * kn) * PROJ_LD + kk * 16);
                }
                const int key = 32 * kt + r32;
#pragma unroll
                for (int rt = 0; rt < 2; ++rt) {
                    f32x16 acc = f32x16{};
#pragma unroll
                    for (int kk = 0; kk < 4; ++kk) acc = __builtin_amdgcn_mfma_f32_32x32x16_bf16(af[rt][kk], bcur[kk], acc, 0, 0, 0);
#pragma unroll
                    for (int qq = 0; qq < 2; ++qq) { float s = 0.f;
#pragma unroll
                        for (int e = 0; e < 8; ++e) s += wq[rt][qq][e] * fmaxf(acc[8 * qq + e], 0.f);
                        ((LAS float*)lds)[(4 * rt + 2 * hi + qq) * 4096 + key] = s;
                        const bool ok = key <= t0 + 4 * rt + 2 * hi + qq;
                        rmax[rt][qq] = fmaxf(rmax[rt][qq], ok ? s : -INFINITY); rmin[rt][qq] = fminf(rmin[rt][qq], ok ? s : INFINITY); }
                }
#pragma unroll
                for (int kk = 0; kk < 4; ++kk) bcur[kk] = bnxt[kk];
                kt = kn;
            }
#pragma unroll
            for (int rt = 0; rt < 2; ++rt)
#pragma unroll
                for (int qq = 0; qq < 2; ++qq) {
#pragma unroll
                    for (int o = 1; o < 32; o <<= 1) { rmax[rt][qq] = fmaxf(rmax[rt][qq], __shfl_xor(rmax[rt][qq], o)); rmin[rt][qq] = fminf(rmin[rt][qq], __shfl_xor(rmin[rt][qq], o)); }
                    if (r32 == 0) { pmm[(wid * 8 + 4 * rt + 2 * hi + qq) * 2] = rmax[rt][qq]; pmm[(wid * 8 + 4 * rt + 2 * hi + qq) * 2 + 1] = rmin[rt][qq]; } }
        }
        __syncthreads();
        {
            const LAS float* row = (const LAS float*)lds + wid * 4096;
            float vmax = -INFINITY, vmin = INFINITY;
#pragma unroll
            for (int w = 0; w < NWAVE; ++w) { vmax = fmaxf(vmax, pmm[(w * 8 + wid) * 2]); vmin = fminf(vmin, pmm[(w * 8 + wid) * 2 + 1]); }
            const int nI4 = (t >> 8) + 1;
            float lo = vmin, sc = (vmax > vmin) ? 511.f / (vmax - vmin) : 0.f;
            float lo0 = 0.f, sc0 = 0.f, lo1 = 0.f, sc1 = 0.f; int b0 = 0, b1 = 0;
            unsigned need = 256u, base = 0u;
            bool by_index = false;
            LAS unsigned* cl = hist;
#define BINL(x, l, s) min((int)(((x) - (l)) * (s)), 511)
#define ACTIVE(x, idx) (((idx) <= t) & ((lev < 1) | (BINL(x, lo0, sc0) == b0)) & ((lev < 2) | (BINL(x, lo1, sc1) == b1)))
#pragma unroll 1
            for (int lev = 0; ; ++lev) {
#pragma unroll
                for (int i = 0; i < 9; ++i) if (lane + 64 * i < 520) hist[lane + 64 * i] = 0u;
                if (lev == 0) {
#pragma unroll 2
                    for (int i = 0; i < nI4; ++i) { const f32x4 x4 = *(const LAS f32x4*)(row + 256 * i + 4 * lane);
#pragma unroll
                        for (int e = 0; e < 4; ++e) { const int idx = 256 * i + 4 * lane + e; const int bn = (idx <= t) ? BINL(x4[e], lo, sc) : 512 + (lane & 7);
                            __hip_atomic_fetch_add(hist + bn, 1u, __ATOMIC_RELAXED, __HIP_MEMORY_SCOPE_WORKGROUP); } }
                } else {
#pragma unroll 2
                for (int i = 0; i < nI4; ++i) { const f32x4 x4 = *(const LAS f32x4*)(row + 256 * i + 4 * lane);
#pragma unroll
                    for (int e = 0; e < 4; ++e) { const int idx = 256 * i + 4 * lane + e; const float ve = by_index ? -(float)idx : x4[e]; const int bn = ACTIVE(x4[e], idx) ? BINL(ve, lo, sc) : 512 + (lane & 7);
                        __hip_atomic_fetch_add(hist + bn, 1u, __ATOMIC_RELAXED, __HIP_MEMORY_SCOPE_WORKGROUP); } }
                }
                LDS_WAIT();
                unsigned c[8]; unsigned lsum = 0;
                { const u32x4 h0 = *(const LAS u32x4*)(hist + 8 * lane), h1 = *(const LAS u32x4*)(hist + 8 * lane + 4);
                  c[0] = h0.x; c[1] = h0.y; c[2] = h0.z; c[3] = h0.w; c[4] = h1.x; c[5] = h1.y; c[6] = h1.z; c[7] = h1.w; }
#pragma unroll
                for (int i = 0; i < 8; ++i) lsum += c[i];
                unsigned sfx = lsum;
#pragma unroll
                for (int o = 1; o < 64; o <<= 1) { const unsigned x = __shfl_down(sfx, o); if (lane + o < 64) sfx += x; }
                unsigned cum = sfx - lsum; int bst = -1; unsigned cab = 0, ceq = 0;
#pragma unroll
                for (int i = 7; i >= 0; --i) { if (cum < need && cum + c[i] >= need) { bst = 8 * lane + i; cab = cum; ceq = c[i]; } cum += c[i]; }
                const unsigned long long bm = __ballot(bst >= 0);
                const int src = __builtin_amdgcn_readfirstlane((int)__builtin_ctzll(bm));
                const int bstar = __builtin_amdgcn_readfirstlane(__shfl(bst, src));
                const unsigned cnt_above = (unsigned)__builtin_amdgcn_readfirstlane((int)__shfl(cab, src)), cnt_eq = (unsigned)__builtin_amdgcn_readfirstlane((int)__shfl(ceq, src));
                need -= cnt_above;
                LDS_WAIT();
                const bool fast = cnt_eq <= 64u;
                unsigned cb2 = 0; float amax = -INFINITY, amin = INFINITY;
                if (lev == 0) {
#pragma unroll 1
                for (int i = 0; i < nI4; ++i) { const f32x4 x4 = *(const LAS f32x4*)(row + 256 * i + 4 * lane);
                    const int idx0 = 256 * i + 4 * lane;
                    bool sv[4], ev[4]; float vv[4]; unsigned ns = 0;
#pragma unroll
                    for (int e = 0; e < 4; ++e) { const int idx = idx0 + e; const bool act = idx <= t; vv[e] = x4[e]; const int bn = BINL(vv[e], lo, sc);
                        sv[e] = act & (bn > bstar); ev[e] = act & (bn == bstar); ns += sv[e] ? 1u : 0u; }
                    const unsigned long long m1 = __ballot(ns & 1u), m2 = __ballot(ns & 2u), m4 = __ballot(ns & 4u);
                    unsigned pos = base + __builtin_amdgcn_mbcnt_hi((unsigned)(m1 >> 32), __builtin_amdgcn_mbcnt_lo((unsigned)m1, 0u))
                                        + 2u * __builtin_amdgcn_mbcnt_hi((unsigned)(m2 >> 32), __builtin_amdgcn_mbcnt_lo((unsigned)m2, 0u))
                                        + 4u * __builtin_amdgcn_mbcnt_hi((unsigned)(m4 >> 32), __builtin_amdgcn_mbcnt_lo((unsigned)m4, 0u));
                    base += (unsigned)__builtin_popcountll(m1) + 2u * (unsigned)__builtin_popcountll(m2) + 4u * (unsigned)__builtin_popcountll(m4);
#pragma unroll
                    for (int e = 0; e < 4; ++e) { listA[sv[e] ? pos : 256u + (unsigned)lane] = (unsigned short)(idx0 + e); pos += sv[e] ? 1u : 0u; }
                    const bool anye = ev[0] | ev[1] | ev[2] | ev[3];
                    if (fast) {
                        if (__ballot(anye) != 0ull) {
#pragma unroll
                            for (int e = 0; e < 4; ++e) { const unsigned long long me = __ballot(ev[e]);
                                if (ev[e]) { const unsigned cp = cb2 + __builtin_amdgcn_mbcnt_hi((unsigned)(me >> 32), __builtin_amdgcn_mbcnt_lo((unsigned)me, 0u)); cl[cp] = (unsigned)(idx0 + e); cl[64 + cp] = __builtin_bit_cast(unsigned, vv[e]); }
                                cb2 += (unsigned)__builtin_popcountll(me); } }
                    } else {
#pragma unroll
                        for (int e = 0; e < 4; ++e) { amax = fmaxf(amax, ev[e] ? vv[e] : -INFINITY); amin = fminf(amin, ev[e] ? vv[e] : INFINITY); }
                    } }
                } else {
#pragma unroll 1
                for (int i = 0; i < nI4; ++i) { const f32x4 x4 = *(const LAS f32x4*)(row + 256 * i + 4 * lane);
                    const int idx0 = 256 * i + 4 * lane;
                    bool sv[4], ev[4]; float vv[4]; unsigned ns = 0;
#pragma unroll
                    for (int e = 0; e < 4; ++e) { const int idx = idx0 + e; const bool act = ACTIVE(x4[e], idx); vv[e] = by_index ? -(float)idx : x4[e]; const int bn = BINL(vv[e], lo, sc);
                        sv[e] = act & (bn > bstar); ev[e] = act & (bn == bstar); ns += sv[e] ? 1u : 0u; }
                    const unsigned long long m1 = __ballot(ns & 1u), m2 = __ballot(ns & 2u), m4 = __ballot(ns & 4u);
                    unsigned pos = base + __builtin_amdgcn_mbcnt_hi((unsigned)(m1 >> 32), __builtin_amdgcn_mbcnt_lo((unsigned)m1, 0u))
                                        + 2u * __builtin_amdgcn_mbcnt_hi((unsigned)(m2 >> 32), __builtin_amdgcn_mbcnt_lo((unsigned)m2, 0u))
                                        + 4u * __builtin_amdgcn_mbcnt_hi((unsigned)(m4 >> 32), __builtin_amdgcn_mbcnt_lo((unsigned)m4, 0u));
                    base += (unsigned)__builtin_popcountll(m1) + 2u * (unsigned)__builtin_popcountll(m2) + 4u * (unsigned)__builtin_popcountll(m4);
#pragma unroll
                    for (int e = 0; e < 4; ++e) { listA[sv[e] ? pos : 256u + (unsigned)lane] = (unsigned short)(idx0 + e); pos += sv[e] ? 1u : 0u; }
                    const bool anye = ev[0] | ev[1] | ev[2] | ev[3];
                    if (fast) {
                        if (__ballot(anye) != 0ull) {
#pragma unroll
                            for (int e = 0; e < 4; ++e) { const unsigned long long me = __ballot(ev[e]);
                                if (ev[e]) { const unsigned cp = cb2 + __builtin_amdgcn_mbcnt_hi((unsigned)(me >> 32), __builtin_amdgcn_mbcnt_lo((unsigned)me, 0u)); cl[cp] = (unsigned)(idx0 + e); cl[64 + cp] = __builtin_bit_cast(unsigned, vv[e]); }
                                cb2 += (unsigned)__builtin_popcountll(me); } }
                    } else {
#pragma unroll
                        for (int e = 0; e < 4; ++e) { amax = fmaxf(amax, ev[e] ? vv[e] : -INFINITY); amin = fminf(amin, ev[e] ? vv[e] : INFINITY); }
                    } }
                }
                if (fast) {
                    LDS_WAIT();
                    const bool have = (unsigned)lane < cnt_eq;
                    const unsigned myi = have ? cl[lane] : 0xffffffffu; const float myv = have ? __builtin_bit_cast(float, cl[64 + lane]) : -INFINITY;
                    unsigned rank = 0;
                    for (unsigned j2 = 0; j2 < cnt_eq; ++j2) { const float vj = __shfl(myv, (int)j2); const unsigned ij = __shfl(myi, (int)j2); rank += (vj > myv || (vj == myv && ij < myi)) ? 1u : 0u; }
                    const bool s = have && rank < need; const unsigned long long m = __ballot(s);
                    if (s) listA[base + __builtin_amdgcn_mbcnt_hi((unsigned)(m >> 32), __builtin_amdgcn_mbcnt_lo((unsigned)m, 0u))] = (unsigned short)myi;
                    break;
                }
#pragma unroll
                for (int o = 1; o < 64; o <<= 1) { amax = fmaxf(amax, __shfl_xor(amax, o)); amin = fminf(amin, __shfl_xor(amin, o)); }
                if (lev < 2 && !by_index) {
                    if (lev == 0) { lo0 = lo; sc0 = sc; b0 = bstar; } else { lo1 = lo; sc1 = sc; b1 = bstar; }
                    if (amax > amin) { lo = amin; sc = 511.f / (amax - amin); }
                    else { by_index = true; lo = -(float)t; sc = 511.f / (float)t; }
                    continue;
                }
                {
                    const int nI = (t >> 6) + 1;
                    const unsigned kmin = sortkey(amin), kmax = sortkey(amax), kdiff = kmin ^ kmax; const int nb = kdiff ? 32 - __builtin_clz(kdiff) : 0;
                    unsigned tau = nb >= 32 ? 0u : ((kmax >> nb) << nb);
#define CAND(x, idx) (ACTIVE(x, idx) && BINL(x, lo, sc) == bstar)
#pragma unroll 1
                    for (int bit = nb - 1; bit >= 0; --bit) { const unsigned trial = tau | (1u << bit); unsigned cnt = 0;
#pragma unroll 2
                        for (int i = 0; i < nI; ++i) { const int idx = lane + 64 * i; const float x = row[idx]; cnt += (CAND(x, idx) && sortkey(x) >= trial) ? 1u : 0u; }
#pragma unroll
                        for (int o = 1; o < 64; o <<= 1) cnt += __shfl_xor(cnt, o);
                        if (cnt >= need) tau = trial; }
                    unsigned cg = 0;
#pragma unroll 2
                    for (int i = 0; i < nI; ++i) { const int idx = lane + 64 * i; const float x = row[idx]; cg += (CAND(x, idx) && sortkey(x) > tau) ? 1u : 0u; }
#pragma unroll
                    for (int o = 1; o < 64; o <<= 1) cg += __shfl_xor(cg, o);
                    unsigned ties = need - cg;
#pragma unroll 1
                    for (int i = 0; i < nI; ++i) { const int idx = lane + 64 * i; const float x = row[idx]; const bool cand = CAND(x, idx); const unsigned kx = sortkey(x);
                        const bool gt = cand && kx > tau, eq = cand && kx == tau; const unsigned long long me = __ballot(eq);
                        const unsigned eoff = __builtin_amdgcn_mbcnt_hi((unsigned)(me >> 32), __builtin_amdgcn_mbcnt_lo((unsigned)me, 0u));
                        const bool s = gt || (eq && eoff < ties); const unsigned long long m = __ballot(s);
                        if (s) listA[base + __builtin_amdgcn_mbcnt_hi((unsigned)(m >> 32), __builtin_amdgcn_mbcnt_lo((unsigned)m, 0u))] = (unsigned short)idx;
                        base += (unsigned)__builtin_popcountll(m); const unsigned ne = (unsigned)__builtin_popcountll(me); ties = ties > ne ? ties - ne : 0u; }
#undef CAND
                    break;
                }
            }
#undef ACTIVE
#undef BINL
            LDS_WAIT();
            *(u32x2*)(selrow + 4 * lane) = *(const LAS u32x2*)(listA + 4 * lane);
        }
        __syncthreads();
    }
}

__device__ __forceinline__ unsigned off_b(unsigned row, unsigned ch) { return 256u * row + 16u * (ch ^ (((row & 3) << 2) | ((row >> 2) & 3))); }
__device__ __forceinline__ void dsa_attn_phase(const bf16_t* PJ, const float* rk, const unsigned short* SEL, const float* biasd, const float* qg, const float* kg, bf16_t* OL, LAS unsigned char* lds) {
    const int tid = fresh_tid(), lane = tid & 63, c16 = lane & 15, G = lane >> 4;
    const int wid = __builtin_amdgcn_readfirstlane(tid >> 6);
    LAS float* biasS = (LAS float*)(lds + 135168);
    for (int e = tid; e < 2048; e += NTHR) biasS[e] = biasd[e];
    if (tid < 16) biasS[2048 + tid] = -INFINITY;
    __syncthreads();
    LAS unsigned char* tile = lds + wid * 16896;
    LAS int* selS = (LAS int*)(tile + 16384);
    LAS float* rS = (LAS float*)(tile + 16384 + 256);
    const int gw = blockIdx.x * NWAVE + wid, NGW = gridDim.x * NWAVE;
    float bmax = -INFINITY;
#pragma unroll 4
    for (int d = G * 32; d < G * 32 + 32; ++d) bmax = fmaxf(bmax, biasS[d * 16 + c16]);
    bmax = fmaxf(bmax, __shfl_xor(bmax, 16)); bmax = fmaxf(bmax, __shfl_xor(bmax, 32));
    u32x4 selreg = (u32x4){0u, 0u, 0u, 0u};
    if (gw < TOK) { const unsigned short* sp = SEL + (size_t)gw * 256 + lane; selreg = (u32x4){sp[0], sp[64], sp[128], sp[192]}; }
#pragma unroll 1
    for (int qi = gw; qi < TOK; qi += NGW) {
        const int b = qi >> 12, t = qi & 4095;
        const size_t rowbase = (size_t)b * SEQ;
        const int count = (t + 1 < 256) ? t + 1 : 256;
        const int nch = (count + 63) >> 6;
        const bf16_t* latb = PJ + rowbase * PROJ_LD + PJ_LAT + c16 * 8;
        int sl = (lane < count) ? (int)selreg[0] : 0;
        float rkv = rk[rowbase + sl];
        u32x4 gr[16];
#pragma unroll
        for (int i = 0; i < 16; ++i) { const int srow = __shfl(sl, 4 * i + G); gr[i] = *(const u32x4*)(latb + (size_t)srow * PROJ_LD); }
        bf16x8 qf[4]; float mshift;
        {
            float qv[4][8]; float ss = 0.f;
#pragma unroll
            for (int kk = 0; kk < 4; ++kk) { const u32x4 w = *(const u32x4*)(PJ + (rowbase + t) * PROJ_LD + c16 * 128 + 32 * kk + 8 * G);
                qv[kk][0] = bflo(w.x); qv[kk][1] = bfhi(w.x); qv[kk][2] = bflo(w.y); qv[kk][3] = bfhi(w.y); qv[kk][4] = bflo(w.z); qv[kk][5] = bfhi(w.z); qv[kk][6] = bflo(w.w); qv[kk][7] = bfhi(w.w);
#pragma unroll
                for (int j = 0; j < 8; ++j) ss += qv[kk][j] * qv[kk][j]; }
            ss += __shfl_xor(ss, 16); ss += __shfl_xor(ss, 32);
            const float rinv = rsqrtf(ss * (1.f / 128.f) + RMS_EPS) * (0.08838834764831845f * LOG2E);
            float qn = 0.f;
#pragma unroll
            for (int kk = 0; kk < 4; ++kk) { const int d = 32 * kk + 8 * G;
                const f32x4 g0 = *(const f32x4*)(qg + d), g1 = *(const f32x4*)(qg + d + 4), h0 = *(const f32x4*)(kg + d), h1 = *(const f32x4*)(kg + d + 4);
                u32x4 w; w.x = pg8::cvt_pk_bf16(qv[kk][0] * rinv * g0[0] * h0[0], qv[kk][1] * rinv * g0[1] * h0[1]); w.y = pg8::cvt_pk_bf16(qv[kk][2] * rinv * g0[2] * h0[2], qv[kk][3] * rinv * g0[3] * h0[3]);
                w.z = pg8::cvt_pk_bf16(qv[kk][4] * rinv * g1[0] * h1[0], qv[kk][5] * rinv * g1[1] * h1[1]); w.w = pg8::cvt_pk_bf16(qv[kk][6] * rinv * g1[2] * h1[2], qv[kk][7] * rinv * g1[3] * h1[3]);
                qf[kk] = __builtin_bit_cast(bf16x8, w);
                qn += bflo(w.x) * bflo(w.x) + bfhi(w.x) * bfhi(w.x) + bflo(w.y) * bflo(w.y) + bfhi(w.y) * bfhi(w.y) + bflo(w.z) * bflo(w.z) + bfhi(w.z) * bfhi(w.z) + bflo(w.w) * bflo(w.w) + bfhi(w.w) * bfhi(w.w); }
            qn += __shfl_xor(qn, 16); qn += __shfl_xor(qn, 32);
            mshift = sqrtf(qn) * 11.313708498984761f * 1.01f + bmax;
        }
        f32x4 o[8];
#pragma unroll
        for (int dt = 0; dt < 8; ++dt) o[dt] = (f32x4){0.f, 0.f, 0.f, 0.f};
        float lrun = 0.f;
        u32x4 selnext = selreg;
#pragma unroll 1
        for (int ch = 0; ch < nch; ++ch) {
            { const bool vk = ch * 64 + lane < count; int dist = t - sl; dist = dist < 0 ? 0 : (dist > 127 ? 127 : dist);
              selS[lane] = vk ? dist * 16 : 2048; rS[lane] = vk ? rkv : 0.f; }
#pragma unroll
            for (int i = 0; i < 16; ++i) *(LAS u32x4*)(tile + off_b(4 * i + G, c16)) = gr[i];
            if (ch + 1 < nch) {
                const unsigned sv = (ch == 0) ? selreg[1] : (ch == 1) ? selreg[2] : selreg[3];
                sl = ((ch + 1) * 64 + lane < count) ? (int)sv : 0;
                rkv = rk[rowbase + sl];
#pragma unroll
                for (int i = 0; i < 16; ++i) { const int srow = __shfl(sl, 4 * i + G); gr[i] = *(const u32x4*)(latb + (size_t)srow * PROJ_LD); }
            } else if (qi + NGW < TOK) {
                const unsigned short* sp = SEL + (size_t)(qi + NGW) * 256 + lane; selnext = (u32x4){sp[0], sp[64], sp[128], sp[192]};
            }
            LDS_WAIT();
            float pl[4][4];
#pragma unroll
            for (int kt4 = 0; kt4 < 4; ++kt4) {
                const unsigned arow = 32 * (kt4 >> 1) + 8 * (c16 >> 2) + 4 * (kt4 & 1) + (c16 & 3);
                f32x4 acc = (f32x4){0.f, 0.f, 0.f, 0.f};
#pragma unroll
                for (int kk = 0; kk < 4; ++kk) { const bf16x8 a = *(const LAS bf16x8*)(tile + off_b(arow, 4 * kk + G)); acc = __builtin_amdgcn_mfma_f32_16x16x32_bf16(a, qf[kk], acc, 0, 0, 0); }
                const int rho = 32 * (kt4 >> 1) + 8 * G + 4 * (kt4 & 1);
                const u32x4 s4 = *(const LAS u32x4*)(selS + rho); const f32x4 r4 = *(const LAS f32x4*)(rS + rho);
#pragma unroll
                for (int reg = 0; reg < 4; ++reg) { const float lg = acc[reg] * r4[reg] + biasS[(int)s4[reg] + c16];
                    pl[kt4][reg] = __builtin_amdgcn_exp2f(lg - mshift); lrun += pl[kt4][reg]; }
            }
            bf16x8 pf[2];
#pragma unroll
            for (int ks = 0; ks < 2; ++ks) { u32x4 w; w.x = pg8::cvt_pk_bf16(pl[2 * ks][0], pl[2 * ks][1]); w.y = pg8::cvt_pk_bf16(pl[2 * ks][2], pl[2 * ks][3]);
                w.z = pg8::cvt_pk_bf16(pl[2 * ks + 1][0], pl[2 * ks + 1][1]); w.w = pg8::cvt_pk_bf16(pl[2 * ks + 1][2], pl[2 * ks + 1][3]); pf[ks] = __builtin_bit_cast(bf16x8, w); }
            const unsigned q4 = (lane & 15) >> 2, p4 = lane & 3;
#pragma unroll
            for (int dt = 0; dt < 8; ++dt) {
#pragma unroll
                for (int ks = 0; ks < 2; ++ks) {
                    const s16x4 lo = __builtin_bit_cast(s16x4, __builtin_amdgcn_ds_read_tr16_b64_v4i16((LAS s16x4*)(tile + off_b(32 * ks + 8 * G + q4, 2 * dt + (p4 >> 1)) + 8 * (p4 & 1))));
                    const s16x4 hh = __builtin_bit_cast(s16x4, __builtin_amdgcn_ds_read_tr16_b64_v4i16((LAS s16x4*)(tile + off_b(32 * ks + 8 * G + 4 + q4, 2 * dt + (p4 >> 1)) + 8 * (p4 & 1))));
                    const bf16x8 vf = (bf16x8){lo[0], lo[1], lo[2], lo[3], hh[0], hh[1], hh[2], hh[3]};
                    o[dt] = __builtin_amdgcn_mfma_f32_16x16x32_bf16(vf, pf[ks], o[dt], 0, 0, 0);
                }
            }
            LDS_WAIT();
        }
        selreg = selnext;
        lrun += __shfl_xor(lrun, 16); lrun += __shfl_xor(lrun, 32);
        const float inv = 1.f / lrun;
        bf16_t* op = OL + (rowbase + t) * 2048 + c16 * 128 + 4 * G;
#pragma unroll
        for (int dt = 0; dt < 8; ++dt) { u32x2 w; w.x = pg8::cvt_pk_bf16(o[dt][0] * inv, o[dt][1] * inv); w.y = pg8::cvt_pk_bf16(o[dt][2] * inv, o[dt][3] * inv); *(u32x2*)(op + 16 * dt) = w; }
    }
}

template <class Epi> __device__ __forceinline__ void run_gemm(LAS unsigned char* lds, const bf16_t* A, const bf16_t* Bt, int N, int K, const Epi& E) {
    pg8::Gemm g{A, Bt, TOK, N, K}; pg8::StaticOrder S; S.init(TOK, N, (int)gridDim.x, (int)blockIdx.x);
    pg8::gemm_phase<Epi, pg8::StaticOrder, true, true>(lds, g, S, E);
}

#define RLX_AGENT __ATOMIC_RELAXED, __HIP_MEMORY_SCOPE_AGENT
#define XB_TMO      128
#define XB_XCNT(j)  (256  + 64 * (j))
#define XB_XSUB(j)  (1280 + 64 * (j))
#define XB_XGEN(j)  (2304 + 64 * (j))
#define XB_TOP      3328
#define XB_TOPGEN   3392
#define XCD_BAR_WORDS 3456
#define XB_SPIN_CAP (1u << 18)

__device__ __forceinline__ unsigned xb_ld(unsigned* p)              { return __hip_atomic_load(p, __ATOMIC_RELAXED, __HIP_MEMORY_SCOPE_AGENT); }
__device__ __forceinline__ unsigned xb_add(unsigned* p, unsigned v) { return __hip_atomic_fetch_add(p, v, __ATOMIC_RELAXED, __HIP_MEMORY_SCOPE_AGENT); }
__device__ __forceinline__ unsigned xb_xcc_id() { return (unsigned)__builtin_amdgcn_s_getreg((3 << 11) | 20) & 0xFu; }
#define XB_SPIN(cond, bar) do { unsigned _sp = 0; while (cond) { __builtin_amdgcn_s_sleep(1); \
    if ((++_sp & 255u) == 0u) { if (xb_ld(&(bar)[XB_TMO])) break; if (_sp > XB_SPIN_CAP) { atomicAdd(&(bar)[XB_TMO], 1u); break; } } } } while (0)

struct XcdBarrier {
    unsigned* bar; unsigned x;
    volatile LAS unsigned* st;
};

__device__ __forceinline__ XcdBarrier xcd_barrier_post(unsigned* bar, volatile LAS unsigned* st) {
    XcdBarrier b; b.bar = bar; b.x = xb_xcc_id(); b.st = st;
    if (threadIdx.x == 0) (void)xb_add(&bar[XB_XCNT(b.x)], 1u);
    return b;
}
__device__ __forceinline__ void xcd_barrier_complete(unsigned* bar, unsigned x, unsigned& nloc, unsigned& nx) {
    const unsigned G = gridDim.x * gridDim.y * gridDim.z;
    unsigned sum, cnt, mine, sp = 0u;
    for (;;) {
        sum = 0u; cnt = 0u; mine = 0u;
#pragma unroll
        for (unsigned j = 0; j < 16; ++j) { const unsigned c = xb_ld(&bar[XB_XCNT(j)]); sum += c; cnt += (c > 0u) ? 1u : 0u; mine = (j == x) ? c : mine; }
        if (sum == G) break;
        __builtin_amdgcn_s_sleep(1);
        if ((++sp & 255u) == 0u) { if (xb_ld(&bar[XB_TMO])) break; if (sp > XB_SPIN_CAP) { atomicAdd(&bar[XB_TMO], 1u); break; } }
    }
    nloc = mine > 0u ? mine : 1u; nx = cnt > 0u ? cnt : 1u;
}

__device__ __forceinline__ void xcd_barrier(const XcdBarrier& b) {
    asm volatile("s_waitcnt vmcnt(0)" ::: "memory");
    __syncthreads();
    if (threadIdx.x == 0) {
        unsigned* bar = b.bar;
        __builtin_amdgcn_s_waitcnt(0);
        unsigned nloc = b.st[0], nx = b.st[1];
        if (nloc == 0u) { xcd_barrier_complete(bar, b.x, nloc, nx); b.st[0] = nloc; b.st[1] = nx; }
        const unsigned old = xb_add(&bar[XB_XSUB(b.x)], 1u);
        const unsigned gen = old / nloc;
        if (old + 1u == (gen + 1u) * nloc) {
            __builtin_amdgcn_fence(__ATOMIC_RELEASE, "agent");
            asm volatile("s_waitcnt vmcnt(0)" ::: "memory");
            const unsigned og = xb_add(&bar[XB_TOP], 1u);
            const unsigned tg = og / nx;
            if (og + 1u == (tg + 1u) * nx) xb_add(&bar[XB_TOPGEN], 1u);
            else XB_SPIN(xb_ld(&bar[XB_TOPGEN]) == tg, bar);
            __builtin_amdgcn_fence(__ATOMIC_ACQUIRE, "agent");
            xb_add(&bar[XB_XGEN(b.x)], 1u);
            asm volatile("s_waitcnt vmcnt(0)" ::: "memory");
        } else {
            XB_SPIN(xb_ld(&bar[XB_XGEN(b.x)]) == gen, bar);
            __builtin_amdgcn_fence(__ATOMIC_ACQUIRE, "agent");
            asm volatile("s_waitcnt vmcnt(0)" ::: "memory");
        }
    }
    __syncthreads();
}

typedef const Params __attribute__((address_space(4)))* KArgs;
#define PHASE_BEGIN { KArgs q = (KArgs)__builtin_amdgcn_kernarg_segment_ptr(); asm volatile("" : "+s"(q)); unsigned char* ws = q->ws; (void)ws;
#define PHASE_END } GRID_SYNC();
#define GRID_SYNC() xcd_barrier(bar)
#define WSP(T, off) ((T*)(ws + (off)))
__global__ void __launch_bounds__(NTHR, 2) mega_fwd(Params p_unused) {
    extern __shared__ __attribute__((aligned(16))) unsigned char lds_raw[];
    LAS unsigned char* lds = (LAS unsigned char*)lds_raw;
    cg::grid_group grid = cg::this_grid();
    volatile LAS unsigned* st = (volatile LAS unsigned*)(lds + LDS_PHASE_BYTES);
    if (threadIdx.x < 4) st[threadIdx.x] = 0u;
    __syncthreads();
    XcdBarrier bar;
    { KArgs q = (KArgs)__builtin_amdgcn_kernarg_segment_ptr(); bar = xcd_barrier_post((unsigned*)(q->ws + WS_BAR), st); }

    PHASE_BEGIN { Params p; for (int i = 0; i < 18; ++i) p.in[i] = q->in[i]; p.out = q->out; p.ws = q->ws; p0_prologue(p, lds); }
        if (q->ws == nullptr) grid.sync();
    PHASE_END
    PHASE_BEGIN { Params p; for (int i = 0; i < 18; ++i) p.in[i] = q->in[i]; p.out = q->out; p.ws = q->ws; p0_weights(p, lds); }
        norm_phase(q->in[0], q->in[4], WSP(float, WS_MOD), 0, 1024, WSP(bf16_t, WS_H)); PHASE_END
    PHASE_BEGIN EpiBf16 E{WSP(bf16_t, WS_A), DM, DM, (size_t)TOK * DM, 0.125f * LOG2E}; run_gemm(lds, WSP(bf16_t, WS_H), WSP(bf16_t, WS_WQKV), 3 * DM, DM, E); PHASE_END
    PHASE_BEGIN bf16_t* RA = WSP(bf16_t, WS_A); sb_attn_phase(RA, RA + (size_t)TOK * DM, RA + (size_t)2 * TOK * DM, WSP(bf16_t, WS_B), lds); PHASE_END
    PHASE_BEGIN EpiResid E{q->in[0], q->out, WSP(float, WS_MOD) + 2048}; run_gemm(lds, WSP(bf16_t, WS_B), WSP(bf16_t, WS_WSBO), DM, DM, E); PHASE_END
    PHASE_BEGIN norm_phase(q->out, q->in[5], WSP(float, WS_MOD), 3072, 4096, WSP(bf16_t, WS_H)); PHASE_END
    PHASE_BEGIN EpiConvGate E{WSP(bf16_t, WS_A), WSP(float, WS_HF), WSP(float, WS_HL), q->in[15], q->in[16]}; run_gemm(lds, WSP(bf16_t, WS_H), WSP(bf16_t, WS_WUP0), FFN2, DM, E); PHASE_END
    PHASE_BEGIN fixup_phase(WSP(float, WS_HF), WSP(float, WS_HL), q->in[15], q->in[16], WSP(bf16_t, WS_A)); PHASE_END
    PHASE_BEGIN EpiResid E{q->out, q->out, WSP(float, WS_MOD) + 5120}; run_gemm(lds, WSP(bf16_t, WS_A), WSP(bf16_t, WS_WDN0), DM, FFN, E); PHASE_END
    PHASE_BEGIN norm_phase(q->out, q->in[4] + DM, WSP(float, WS_MOD) + 8 * 6144, 0, 1024, WSP(bf16_t, WS_H)); PHASE_END
    PHASE_BEGIN EpiBf16 E{WSP(bf16_t, WS_A), PROJ_LD, 0, 0, 1.f}; run_gemm(lds, WSP(bf16_t, WS_H), WSP(bf16_t, WS_WDIN), PROJ_LD, DM, E); PHASE_END
    PHASE_BEGIN indexer_phase(WSP(bf16_t, WS_A), WSP(float, WS_RK), WSP(unsigned short, WS_SEL), lds); PHASE_END
    PHASE_BEGIN dsa_attn_phase(WSP(bf16_t, WS_A), WSP(float, WS_RK), WSP(unsigned short, WS_SEL), WSP(float, WS_BIASD), q->in[9], q->in[10], WSP(bf16_t, WS_B), lds); PHASE_END
    PHASE_BEGIN EpiResid E{q->out, q->out, WSP(float, WS_MOD) + 8 * 6144 + 2048}; run_gemm(lds, WSP(bf16_t, WS_B), WSP(bf16_t, WS_WDO), DM, 2 * DM, E); PHASE_END
    PHASE_BEGIN norm_phase(q->out, q->in[5] + DM, WSP(float, WS_MOD) + 8 * 6144, 3072, 4096, WSP(bf16_t, WS_H)); PHASE_END
    PHASE_BEGIN EpiConvGate E{WSP(bf16_t, WS_A), WSP(float, WS_HF), WSP(float, WS_HL), q->in[15] + 3 * FFN2, q->in[16] + FFN2}; run_gemm(lds, WSP(bf16_t, WS_H), WSP(bf16_t, WS_WUP1), FFN2, DM, E); PHASE_END
    PHASE_BEGIN fixup_phase(WSP(float, WS_HF), WSP(float, WS_HL), q->in[15] + 3 * FFN2, q->in[16] + FFN2, WSP(bf16_t, WS_A)); PHASE_END
    { KArgs q = (KArgs)__builtin_amdgcn_kernarg_segment_ptr(); asm volatile("" : "+s"(q)); unsigned char* ws = q->ws;
      EpiResid E{q->out, q->out, WSP(float, WS_MOD) + 8 * 6144 + 5120}; run_gemm(lds, WSP(bf16_t, WS_A), WSP(bf16_t, WS_WDN1), DM, FFN, E); }
}

extern "C" void kernel_launch(void* const* d_in, const int* in_sizes, int n_in, void* d_out, int out_size, void* d_ws, size_t ws_size, hipStream_t stream) {
    static int grid = 0;
    if (grid == 0) {
        if (n_in != 18 || out_size != TOK * DM || ws_size < WS_END) { fprintf(stderr, "kernel_launch: unexpected shapes (n_in %d, out %d, ws %zu)\n", n_in, out_size, ws_size); grid = -1; return; }
        int dev = 0, cus = 0, per_cu = 0;
        hipGetDevice(&dev);
        hipDeviceGetAttribute(&cus, hipDeviceAttributeMultiprocessorCount, dev);
        if (hipFuncSetAttribute((const void*)mega_fwd, hipFuncAttributeMaxDynamicSharedMemorySize, LDS_BYTES) != hipSuccess) { fprintf(stderr, "kernel_launch: hipFuncSetAttribute failed\n"); grid = -1; return; }
        if (hipOccupancyMaxActiveBlocksPerMultiprocessor(&per_cu, (const void*)mega_fwd, NTHR, LDS_BYTES) != hipSuccess || per_cu < 1) { fprintf(stderr, "kernel_launch: occupancy query says %d\n", per_cu); per_cu = 1; }
        (void)hipGetLastError();
        grid = cus * 1;
        fprintf(stderr, "kernel_launch: grid %d (cus %d, per_cu %d)\n", grid, cus, per_cu);
    }
    if (grid < 0) return;
    Params p{};
    for (int i = 0; i < 18; ++i) p.in[i] = (const float*)d_in[i];
    p.out = (float*)d_out; p.ws = (unsigned char*)d_ws;
    void* args[] = {&p};
    if (hipMemsetAsync((char*)d_ws + WS_BAR, 0, XCD_BAR_WORDS * 4, stream) != hipSuccess) { fprintf(stderr, "kernel_launch: memset failed\n"); return; }
    hipError_t e = hipLaunchCooperativeKernel((const void*)mega_fwd, dim3(grid), dim3(NTHR), args, LDS_BYTES, stream);
    if (e != hipSuccess) fprintf(stderr, "cooperative launch failed: %s (grid %d)\n", hipGetErrorString(e), grid);
}
```

```cpp
#include <hip/hip_runtime.h>
#include <hip/hip_cooperative_groups.h>
#include <cstdio>
#include <cstdint>
namespace cg = cooperative_groups;

__device__ __forceinline__ int fresh_tid() { int t = threadIdx.x; asm volatile("" : "+v"(t)); return t; }
namespace pg8 {
#define PG8_LAS __attribute__((address_space(3)))
typedef unsigned short bf16_t;
typedef short bf16x8 __attribute__((ext_vector_type(8)));
typedef float f32x4 __attribute__((ext_vector_type(4)));
typedef unsigned u32x4 __attribute__((ext_vector_type(4)));
constexpr int BM = 256, BK = 64, HALF = 128, HTB = HALF * BK * 2  , STAGE_BYTES = 8 * HTB, NXCD = 8, WGM = 8;

__host__ __device__ __forceinline__ int lds_byte(int r, int c) { const int st = (r >> 4) * 2 + (c >> 5), rr = r & 15, cc = c & 31, ob = rr * 64 + cc * 2; return st * 1024 + (ob ^ (((ob >> 9) & 1) << 5)); }
__host__ __device__ __forceinline__ void stage_rc(int b, int& R, int& C) { const int st = b / 1024, sb = b % 1024, swz = sb ^ (((sb >> 9) & 1) << 5); R = (st >> 1) * 16 + swz / 64; C = (st & 1) * 32 + (swz % 64) / 2; }
__host__ __device__ __forceinline__ int perm32(int rho) { const int n = rho >> 4, i = rho & 15; return 8 * (i >> 2) + 4 * n + (i & 3); }

struct Unit { int pm, pn; };
struct Gemm { const bf16_t* A; const bf16_t* Bt; int M, N, K; };

struct StaticOrder {
    int nM, nN, nwg, G, c;
    __host__ __device__ void init(int M, int N, int G_, int c_) { nM = M / BM; nN = N / BM; nwg = nM * nN; G = G_; c = c_; }
    __host__ __device__ bool next(int i, Unit& u) const {
        const long L = (long)i * G + c; if (L >= nwg) return false;
        int wgid = (int)L; { const int q = nwg / NXCD, r = nwg % NXCD, xcd = wgid % NXCD, off = wgid / NXCD; wgid = (xcd < r ? xcd * (q + 1) : r * (q + 1) + (xcd - r) * q) + off; }
        const int nig = WGM * nN, gid = wgid / nig, fm = gid * WGM, gsz = (nM - fm) < WGM ? (nM - fm) : WGM;
        u.pm = fm + ((wgid % nig) % gsz); u.pn = (wgid % nig) / gsz; return true;
    }
    __device__ __forceinline__ void a_ready(const Unit&) const {}
    __device__ __forceinline__ void done(const Unit&) const {}
};

__device__ __forceinline__ unsigned cvt_pk_bf16(float lo, float hi) { unsigned r; asm volatile("v_cvt_pk_bf16_f32 %0, %1, %2" : "=v"(r) : "v"(lo), "v"(hi)); return r; }
template <class Epi, class Sched, bool ALIGN_EPI = false, bool SP2 = false>
__device__ __forceinline__ void gemm_phase(PG8_LAS unsigned char* lds, const Gemm g, const Sched& S, const Epi& E) {
    const int tid = fresh_tid(), wid = __builtin_amdgcn_readfirstlane(tid >> 6), lane = tid & 63, wr = wid >> 2, wc = wid & 3, fr = lane & 15, fq = lane >> 4;
    const int K = g.K, nt = K / BK;
    unsigned voffA[2], voffB[2];
#pragma unroll
    for (int i = 0; i < 2; ++i) { int R, C; stage_rc(tid * 16 + i * 8192, R, C); const int Rb = Epi::PERM ? ((R & ~31) + perm32(R & 31)) : R;
        voffA[i] = (unsigned)(R * K + C) * 2u; voffB[i] = (unsigned)(Rb * K + C) * 2u; }
    const size_t kstep = (size_t)(BK * 2);
    const size_t hstep = (size_t)HALF * K * 2;
    const size_t tstep = 2 * hstep;
    const unsigned ldsw = (unsigned)wid * 1024u;
    const int aoff = lds_byte(wr * 64 + fr, fq * 8), boff = lds_byte(wc * 32 + fr, fq * 8);
#define PG8_SA(b, h) (((b) * 2 + (h)) * HTB)
#define PG8_SB(b, h) ((4 + (b) * 2 + (h)) * HTB)
#define PG8_STAGE(bufoff, gbase, voff) do { _Pragma("unroll") for (int _i = 0; _i < 2; ++_i) \
        __builtin_amdgcn_global_load_lds((const unsigned*)((const char*)(gbase) + (voff)[_i]), (PG8_LAS unsigned*)(lds + (bufoff) + ldsw + _i * 8192), 16, 0, 0); } while (0)
#define PG8_LDA(dst, b, h) do { _Pragma("unroll") for (int m = 0; m < 4; ++m) _Pragma("unroll") for (int k = 0; k < 2; ++k) dst[m][k] = *(const PG8_LAS bf16x8*)(lds + PG8_SA(b, h) + aoff + m * 2048 + k * 1024); } while (0)
#define PG8_LDB(dst, b, h) do { _Pragma("unroll") for (int n = 0; n < 2; ++n) _Pragma("unroll") for (int k = 0; k < 2; ++k) dst[n][k] = *(const PG8_LAS bf16x8*)(lds + PG8_SB(b, h) + boff + n * 2048 + k * 1024); } while (0)
#define PG8_MMA(ai, bj, At, Bt) do { __builtin_amdgcn_s_setprio(1); _Pragma("unroll") for (int m = 0; m < 4; ++m) _Pragma("unroll") for (int n = 0; n < 2; ++n) _Pragma("unroll") for (int k = 0; k < 2; ++k) \
        acc[ai][bj][m][n] = __builtin_amdgcn_mfma_f32_16x16x32_bf16(Bt[n][k], At[m][k], acc[ai][bj][m][n], 0, 0, 0); __builtin_amdgcn_s_setprio(0); } while (0)
#define PG8_WAIT_V(n) asm volatile("s_waitcnt vmcnt(" #n ")" ::: "memory")
#define PG8_WAIT_L(n) asm volatile("s_waitcnt lgkmcnt(" #n ")" ::: "memory")
#define PG8_BAR __builtin_amdgcn_s_barrier()
#define PG8_SCHED __builtin_amdgcn_sched_barrier(0)
    Unit cur, nxt; int ui = 0;
    if (!S.next(0, cur)) return;
    f32x4 acc[2][2][4][2];
#pragma unroll
    for (int a = 0; a < 2; ++a)
#pragma unroll
        for (int b = 0; b < 2; ++b)
#pragma unroll
            for (int m = 0; m < 4; ++m)
#pragma unroll
                for (int n = 0; n < 2; ++n) acc[a][b][m][n] = (f32x4){0.f, 0.f, 0.f, 0.f};
    bf16x8 At[4][2], B0[2][2], B1[2][2];
    const char* cA = (const char*)g.A + (size_t)cur.pm * tstep; const char* cB = (const char*)g.Bt + (size_t)cur.pn * tstep;
    S.a_ready(cur);
    if constexpr (SP2) {
        PG8_STAGE(PG8_SB(0, 0), cB, voffB); PG8_STAGE(PG8_SB(0, 1), cB + hstep, voffB); PG8_STAGE(PG8_SA(0, 0), cA, voffA); PG8_STAGE(PG8_SA(0, 1), cA + hstep, voffA);
        if (wr == 1) PG8_BAR;
        PG8_WAIT_V(2); PG8_BAR;
        PG8_STAGE(PG8_SB(1, 0), cB + kstep, voffB); PG8_STAGE(PG8_SA(1, 0), cA + kstep, voffA); PG8_STAGE(PG8_SB(1, 1), cB + hstep + kstep, voffB);
        PG8_WAIT_V(6); PG8_BAR;
    } else {
        PG8_STAGE(PG8_SB(0, 0), cB, voffB); PG8_STAGE(PG8_SA(0, 0), cA, voffA); PG8_STAGE(PG8_SB(0, 1), cB + hstep, voffB); PG8_STAGE(PG8_SA(0, 1), cA + hstep, voffA);
        if (wr == 1) PG8_BAR;
        PG8_WAIT_V(4); PG8_BAR;
        PG8_STAGE(PG8_SB(1, 0), cB + kstep, voffB); PG8_STAGE(PG8_SA(1, 0), cA + kstep, voffA); PG8_STAGE(PG8_SB(1, 1), cB + hstep + kstep, voffB);
        PG8_WAIT_V(6); PG8_BAR;
    }
    for (;;) {
        const bool has_next = S.next(ui + 1, nxt);
        const char* nA = has_next ? (const char*)g.A + (size_t)nxt.pm * tstep : cA; const char* nB = has_next ? (const char*)g.Bt + (size_t)nxt.pn * tstep : cB;
        for (int t = 0; t < nt; t += 2) {
            const bool last = (t == nt - 2);
            const char* a1 = cA + (size_t)(t + 1) * kstep;
            const char* a2 = last ? nA : cA + (size_t)(t + 2) * kstep; const char* b2 = last ? nB : cB + (size_t)(t + 2) * kstep;
            const char* a3 = a2 + kstep; const char* b3 = b2 + kstep;
            if (last && has_next) S.a_ready(nxt);
            if constexpr (SP2) {
            PG8_LDB(B0, 0, 0); PG8_LDB(B1, 0, 1); PG8_SCHED; PG8_LDA(At, 0, 0); PG8_STAGE(PG8_SA(1, 1), a1 + hstep, voffA);
            PG8_WAIT_V(8); PG8_WAIT_L(0); PG8_BAR; PG8_MMA(0, 0, At, B0); PG8_MMA(0, 1, At, B1); PG8_BAR; PG8_SCHED;
            PG8_LDA(At, 0, 1); PG8_STAGE(PG8_SB(0, 0), b2, voffB); PG8_STAGE(PG8_SB(0, 1), b2 + hstep, voffB); PG8_STAGE(PG8_SA(0, 0), a2, voffA);
            PG8_WAIT_V(8); PG8_WAIT_L(0); PG8_BAR; PG8_MMA(1, 0, At, B0); PG8_MMA(1, 1, At, B1); PG8_BAR; PG8_SCHED;
            PG8_LDB(B0, 1, 0); PG8_LDB(B1, 1, 1); PG8_SCHED; PG8_LDA(At, 1, 0); PG8_STAGE(PG8_SA(0, 1), a2 + hstep, voffA);
            PG8_WAIT_V(8); PG8_WAIT_L(0); PG8_BAR; PG8_MMA(0, 0, At, B0); PG8_MMA(0, 1, At, B1); PG8_BAR; PG8_SCHED;
            PG8_LDA(At, 1, 1); PG8_STAGE(PG8_SB(1, 0), b3, voffB); PG8_STAGE(PG8_SB(1, 1), b3 + hstep, voffB); PG8_STAGE(PG8_SA(1, 0), a3, voffA);
            PG8_WAIT_V(8); PG8_WAIT_L(0); PG8_BAR; PG8_MMA(1, 0, At, B0); PG8_MMA(1, 1, At, B1); PG8_BAR; PG8_SCHED;
            } else {
            PG8_LDB(B0, 0, 0); PG8_SCHED; PG8_LDA(At, 0, 0); PG8_STAGE(PG8_SA(1, 1), a1 + hstep, voffA);
            PG8_WAIT_L(8); PG8_BAR; PG8_WAIT_L(0); PG8_MMA(0, 0, At, B0); PG8_BAR; PG8_SCHED;
            PG8_LDB(B1, 0, 1); PG8_STAGE(PG8_SB(0, 0), b2, voffB);
            PG8_BAR; PG8_WAIT_L(0); PG8_MMA(0, 1, At, B1); PG8_BAR;
            PG8_LDA(At, 0, 1); PG8_STAGE(PG8_SA(0, 0), a2, voffA);
            PG8_BAR; PG8_WAIT_L(0); PG8_MMA(1, 0, At, B0); PG8_BAR; PG8_SCHED;
            PG8_STAGE(PG8_SB(0, 1), b2 + hstep, voffB);
            PG8_WAIT_V(6); PG8_BAR; PG8_MMA(1, 1, At, B1); PG8_BAR;
            PG8_LDB(B0, 1, 0); PG8_SCHED; PG8_LDA(At, 1, 0); PG8_STAGE(PG8_SA(0, 1), a2 + hstep, voffA);
            PG8_WAIT_L(8); PG8_BAR; PG8_WAIT_L(0); PG8_MMA(0, 0, At, B0); PG8_BAR; PG8_SCHED;
            PG8_LDB(B1, 1, 1); PG8_STAGE(PG8_SB(1, 0), b3, voffB);
            PG8_BAR; PG8_WAIT_L(0); PG8_MMA(0, 1, At, B1); PG8_BAR;
            PG8_LDA(At, 1, 1); PG8_STAGE(PG8_SA(1, 0), a3, voffA);
            PG8_BAR; PG8_WAIT_L(0); PG8_MMA(1, 0, At, B0); PG8_BAR; PG8_SCHED;
            PG8_STAGE(PG8_SB(1, 1), b3 + hstep, voffB);
            PG8_WAIT_V(6); PG8_BAR; PG8_MMA(1, 1, At, B1); PG8_BAR;
            }
        }
        if constexpr (ALIGN_EPI) { if (wr == 0) PG8_BAR; }
        if constexpr (!Epi::AFTER_DRAIN) { E(acc, cur, wr, wc, fr, fq); S.done(cur); }
        if (!has_next) break;
#pragma unroll
        for (int a = 0; a < 2; ++a)
#pragma unroll
            for (int b = 0; b < 2; ++b)
#pragma unroll
                for (int m = 0; m < 4; ++m)
#pragma unroll
                    for (int n = 0; n < 2; ++n) acc[a][b][m][n] = (f32x4){0.f, 0.f, 0.f, 0.f};
        cur = nxt; cA = nA; cB = nB; ++ui;
        if constexpr (ALIGN_EPI) { if (wr == 1) PG8_BAR; }
    }
    PG8_WAIT_V(0);
    if constexpr (!ALIGN_EPI) { if (wr == 0) PG8_BAR; }
    PG8_BAR;
    if constexpr (Epi::AFTER_DRAIN) { E.fused(acc, cur, wr, wc, fr, fq, lds, wid, lane); S.done(cur); }
#undef PG8_SA
#undef PG8_SB
#undef PG8_STAGE
#undef PG8_LDA
#undef PG8_LDB
#undef PG8_MMA
#undef PG8_WAIT_V
#undef PG8_WAIT_L
#undef PG8_BAR
#undef PG8_SCHED
}
}

#define LAS __attribute__((address_space(3)))
typedef unsigned short bf16_t;
typedef short bf16x8 __attribute__((ext_vector_type(8)));
typedef short s16x4 __attribute__((ext_vector_type(4)));
typedef float f32x4 __attribute__((ext_vector_type(4)));
typedef float f32x16 __attribute__((ext_vector_type(16)));
typedef unsigned u32x4 __attribute__((ext_vector_type(4)));
typedef unsigned u32x2 __attribute__((ext_vector_type(2)));

constexpr int DM = 1024, NBATCH = 8, SEQ = 4096, TOK = NBATCH * SEQ, FFN = 2816, FFN2 = 5632;
constexpr int DSA_N = 2760, PROJ_LD = 2816;
constexpr int PJ_LAT = 2048, PJ_QI = 2176, PJ_KI = 2688, PJ_WI = 2752;
constexpr float RMS_EPS = 1e-6f, LOG2E = 1.4426950408889634f;
constexpr int NTHR = 512, NWAVE = 8;
constexpr int LDS_PHASE_BYTES = 156160, LDS_BYTES = LDS_PHASE_BYTES + 64;

constexpr size_t MiB = 1u << 20;
constexpr size_t WS_MOD = 0;
constexpr size_t WS_BIASD = 512 * 1024;
constexpr size_t WS_RK = 1 * MiB;
constexpr size_t WS_BAR = 1536 * 1024;
constexpr size_t WS_WQKV = 2 * MiB;
constexpr size_t WS_WSBO = 8 * MiB;
constexpr size_t WS_WDIN = 10 * MiB;
constexpr size_t WS_WDO = 16 * MiB;
constexpr size_t WS_WUP0 = 20 * MiB, WS_WUP1 = 31 * MiB;
constexpr size_t WS_WDN0 = 42 * MiB, WS_WDN1 = 48 * MiB;
constexpr size_t WS_HF = 54 * MiB, WS_HL = 76 * MiB;
constexpr size_t WS_H = 100 * MiB;
constexpr size_t WS_A = 164 * MiB;
constexpr size_t WS_B = 356 * MiB;
constexpr size_t WS_SEL = 484 * MiB;
constexpr size_t WS_END = 500 * MiB;

struct Params { const float* in[18]; float* out; unsigned char* ws; };

__device__ __forceinline__ unsigned f2bf(float f) { unsigned u = __builtin_bit_cast(unsigned, f); return (u + 0x7fffu + ((u >> 16) & 1u)) >> 16; }
__device__ __forceinline__ unsigned pk2(float lo, float hi) { return f2bf(lo) | (f2bf(hi) << 16); }
__device__ __forceinline__ float bflo(unsigned w) { return __builtin_bit_cast(float, w << 16); }
__device__ __forceinline__ float bfhi(unsigned w) { return __builtin_bit_cast(float, w & 0xffff0000u); }
__device__ __forceinline__ float wave_sum(float v) {
#pragma unroll
    for (int o = 1; o < 64; o <<= 1) v += __shfl_xor(v, o);
    return v;
}
#define LDS_WAIT() asm volatile("s_waitcnt lgkmcnt(0)" ::: "memory")

struct EpiBf16 {
    static constexpr bool PERM = true, AFTER_DRAIN = false;
    bf16_t* O; int ldc; int split_cols; size_t split_stride; float scale0;
    __device__ __forceinline__ void operator()(const f32x4 (&acc)[2][2][4][2], const pg8::Unit& u, int wr, int wc, int fr, int fq) const {
        const int row0 = u.pm * 256 + wr * 64 + fr; int colt = u.pn * 256; bf16_t* base = O;
        float sc = 1.f; if (split_cols) { const int t = colt / split_cols; base += (size_t)t * split_stride; colt -= t * split_cols; if (t == 0) sc = scale0; }
        const int col0 = colt + wc * 32 + 8 * fq;
#pragma unroll
        for (int ai = 0; ai < 2; ++ai)
#pragma unroll
            for (int m = 0; m < 4; ++m) { bf16_t* rowp = base + (size_t)(row0 + ai * 128 + m * 16) * ldc + col0;
#pragma unroll
                for (int bj = 0; bj < 2; ++bj) { const f32x4 v0 = acc[ai][bj][m][0] * sc, v1 = acc[ai][bj][m][1] * sc;
                    u32x4 w; w.x = pg8::cvt_pk_bf16(v0[0], v0[1]); w.y = pg8::cvt_pk_bf16(v0[2], v0[3]); w.z = pg8::cvt_pk_bf16(v1[0], v1[1]); w.w = pg8::cvt_pk_bf16(v1[2], v1[3]);
                    *(u32x4*)(rowp + bj * 128) = w; } }
    }
};
template <int CTRL> __device__ __forceinline__ float dpp_ror(float v) { return __builtin_bit_cast(float, __builtin_amdgcn_update_dpp(0, __builtin_bit_cast(int, v), CTRL, 0xf, 0xf, false)); }
struct EpiResid {
    static constexpr bool PERM = false, AFTER_DRAIN = false;
    const float* resid; float* out; const float* gate;
    __device__ __forceinline__ void operator()(const f32x4 (&acc)[2][2][4][2], const pg8::Unit& u, int wr, int wc, int fr, int fq) const {
        const float* g = gate + (size_t)(u.pm >> 4) * 6144;
        const int col0 = u.pn * 256 + wc * 32 + 4 * fq;
        f32x4 gv[2][2];
#pragma unroll
        for (int bj = 0; bj < 2; ++bj)
#pragma unroll
            for (int n = 0; n < 2; ++n) gv[bj][n] = *(const f32x4*)(g + col0 + bj * 128 + n * 16);
        const bool lo8 = fr < 8;
        const int rsel = fr & 7, csel = lo8 ? 0 : 16;
#pragma unroll
        for (int ai = 0; ai < 2; ++ai)
#pragma unroll
            for (int m = 0; m < 4; ++m) { const size_t off = (size_t)(u.pm * 256 + ai * 128 + wr * 64 + m * 16 + fr) * DM + col0;
                const size_t offs = (size_t)(u.pm * 256 + ai * 128 + wr * 64 + m * 16 + rsel) * DM + col0 + csel;
#pragma unroll
                for (int bj = 0; bj < 2; ++bj) {
                    const f32x4 a = *(const f32x4*)(resid + off + bj * 128) + gv[bj][0] * acc[ai][bj][m][0];
                    const f32x4 b = *(const f32x4*)(resid + off + bj * 128 + 16) + gv[bj][1] * acc[ai][bj][m][1];
                    f32x4 y;
#pragma unroll
                    for (int j = 0; j < 4; ++j) y[j] = dpp_ror<0x128>(lo8 ? b[j] : a[j]);
                    f32x4 s1, s2;
#pragma unroll
                    for (int j = 0; j < 4; ++j) { s1[j] = lo8 ? a[j] : y[j]; s2[j] = lo8 ? y[j] : b[j]; }
                    *(f32x4*)(out + offs + bj * 128) = s1;
                    *(f32x4*)(out + offs + (size_t)8 * DM + bj * 128) = s2;
                }
            }
    }
};
__device__ __forceinline__ float silu_f(float g) { return g * __builtin_amdgcn_rcpf(1.f + __builtin_amdgcn_exp2f(-g * LOG2E)); }
struct EpiConvGate {
    static constexpr bool PERM = true, AFTER_DRAIN = false;
    bf16_t* act; float* hf; float* hl; const float* cw; const float* cb;
    __device__ __forceinline__ void operator()(const f32x4 (&acc)[2][2][4][2], const pg8::Unit& u, int wr, int wc, int fr, int fq) const {
#pragma unroll
        for (int n = 0; n < 2; ++n) {
            const int f0 = u.pn * 128 + wc * 32 + 8 * fq + 4 * n;
            f32x4 w[2][3], bb[2];
#pragma unroll
            for (int bj = 0; bj < 2; ++bj) { const int col = bj * FFN + f0; bb[bj] = *(const f32x4*)(cb + col);
#pragma unroll
                for (int tp = 0; tp < 3; ++tp) w[bj][tp] = *(const f32x4*)(cw + tp * FFN2 + col); }
#pragma unroll
            for (int ai = 0; ai < 2; ++ai) {
                const int wb = (u.pm * 2 + ai) * 2 + wr;
                f32x4 p1[2], p2[2];
                p1[0] = p1[1] = p2[0] = p2[1] = (f32x4){0.f, 0.f, 0.f, 0.f};
#pragma unroll
                for (int m = 0; m < 4; ++m) {
                    f32x4 y[2];
#pragma unroll
                    for (int bj = 0; bj < 2; ++bj) {
                        const f32x4 cur = acc[ai][bj][m][n]; f32x4 r1, r2;
#pragma unroll
                        for (int j = 0; j < 4; ++j) { r1[j] = dpp_ror<0x121>(cur[j]); r2[j] = dpp_ror<0x122>(cur[j]); }
                        const f32x4 s1 = (fr >= 1) ? r1 : p1[bj], s2 = (fr >= 2) ? r2 : p2[bj];
                        y[bj] = bb[bj] + w[bj][0] * s2 + w[bj][1] * s1 + w[bj][2] * cur;
                        p1[bj] = r1; p2[bj] = r2;
                        if (m == 0 && fr < 2) *(f32x4*)(hf + (size_t)(wb * 2 + fr) * FFN2 + bj * FFN + f0) = cur;
                        if (m == 3 && fr >= 14) *(f32x4*)(hl + (size_t)(wb * 2 + fr - 14) * FFN2 + bj * FFN + f0) = cur;
                    }
                    u32x2 o; o.x = pg8::cvt_pk_bf16(silu_f(y[0][0]) * y[1][0], silu_f(y[0][1]) * y[1][1]); o.y = pg8::cvt_pk_bf16(silu_f(y[0][2]) * y[1][2], silu_f(y[0][3]) * y[1][3]);
                    *(u32x2*)(act + (size_t)(wb * 64 + m * 16 + fr) * FFN + f0) = o;
                }
            }
        }
    }
};

__device__ __forceinline__ void transpose_item(const float* W, int K, int N, bf16_t* WT, int dst_row0, LAS float* scr, int k0, int n0, int lane) {
    const int c4 = (lane & 7) * 4, n = n0 + c4;
#pragma unroll
    for (int i = 0; i < 8; ++i) { const int kk = 8 * i + (lane >> 3);
        const f32x4 v = (n < N) ? *(const f32x4*)(W + (size_t)(k0 + kk) * N + n) : (f32x4){0.f, 0.f, 0.f, 0.f};
        scr[kk * 33 + c4] = v[0]; scr[kk * 33 + c4 + 1] = v[1]; scr[kk * 33 + c4 + 2] = v[2]; scr[kk * 33 + c4 + 3] = v[3]; }
    LDS_WAIT();
    const int c = lane & 7;
#pragma unroll
    for (int j = 0; j < 4; ++j) { const int nn = (lane >> 3) + 8 * j; const LAS float* s = scr + (8 * c) * 33 + nn;
        u32x4 o; o.x = pk2(s[0 * 33], s[1 * 33]); o.y = pk2(s[2 * 33], s[3 * 33]); o.z = pk2(s[4 * 33], s[5 * 33]); o.w = pk2(s[6 * 33], s[7 * 33]);
        *(u32x4*)(WT + (size_t)(dst_row0 + nn) * K + k0 + 8 * c) = o; }
    LDS_WAIT();
}
__device__ __forceinline__ int t5_bucket(int n) {
    if (n < 16) return n;
    return 16 + (n >= 19) + (n >= 21) + (n >= 24) + (n >= 27) + (n >= 31) + (n >= 35) + (n >= 40) + (n >= 46) + (n >= 52) + (n >= 59) + (n >= 67) + (n >= 77) + (n >= 87) + (n >= 99) + (n >= 113);
}
__device__ __forceinline__ void p0_prologue(const Params& p, LAS unsigned char* lds) {
    const int tid = fresh_tid(), lane = tid & 63, wave = tid >> 6, G = gridDim.x;
    const int gw = blockIdx.x * NWAVE + wave, NGW = G * NWAVE;
    unsigned char* ws = p.ws;
    {
        LAS float* condS = (LAS float*)lds;
        LAS float* red = (LAS float*)(lds + 32768);
        if ((int)blockIdx.x < 192) {
            for (int e = tid; e < NBATCH * DM; e += NTHR) { const float c = p.in[1][e]; condS[e] = c / (1.f + __expf(-c)); }
            __syncthreads();
        }
        for (int item = blockIdx.x; item < 192; item += G) {
            const int l = item / 96, col0 = (item % 96) * 64, col = tid & 63, kg = tid >> 6;
            const float* W = p.in[2] + (size_t)l * DM * 6144 + col0 + col;
            float a[8];
#pragma unroll
            for (int b = 0; b < 8; ++b) a[b] = 0.f;
#pragma unroll 8
            for (int k = kg * 128; k < kg * 128 + 128; ++k) { const float w = W[(size_t)k * 6144];
#pragma unroll
                for (int b = 0; b < 8; ++b) a[b] += condS[b * DM + k] * w; }
#pragma unroll
            for (int b = 0; b < 8; ++b) red[(kg * 8 + b) * 64 + col] = a[b];
            __syncthreads();
            { const int b = tid >> 6; float s = 0.f;
#pragma unroll
              for (int g = 0; g < 8; ++g) s += red[(g * 8 + b) * 64 + col];
              ((float*)(ws + WS_MOD))[(size_t)(l * 8 + b) * 6144 + col0 + col] = s + p.in[3][l * 6144 + col0 + col]; }
            __syncthreads();
        }
        __syncthreads();
    }
    { const int g = blockIdx.x * NTHR + tid; if (g < 2048) ((float*)(ws + WS_BIASD))[g] = p.in[13][t5_bucket(g >> 4) * 16 + (g & 15)] * LOG2E; }
}
__device__ __forceinline__ void p0_weights(const Params& p, LAS unsigned char* lds) {
    const int tid = fresh_tid(), lane = tid & 63, wave = tid >> 6, G = gridDim.x;
    const int gw = blockIdx.x * NWAVE + wave, NGW = G * NWAVE;
    unsigned char* ws = p.ws;
    {
        LAS float* scr = (LAS float*)(lds + wave * 16384);
        for (int it = gw; it < 11904; it += NGW) {
            const float* W; int K, N, nblk, mode = 0, r = it; bf16_t* WT;
            if (r < 1536) { W = p.in[6]; K = 1024; N = 3072; nblk = 96; WT = (bf16_t*)(ws + WS_WQKV); }
            else if ((r -= 1536) < 512) { W = p.in[7]; K = 1024; N = 1024; nblk = 32; WT = (bf16_t*)(ws + WS_WSBO); }
            else if ((r -= 512) < 1408) { W = p.in[8]; K = 1024; N = DSA_N; nblk = 88; WT = (bf16_t*)(ws + WS_WDIN); }
            else if ((r -= 1408) < 2816) { W = p.in[14]; K = 1024; N = FFN2; nblk = 176; WT = (bf16_t*)(ws + WS_WUP0); mode = 1; }
            else if ((r -= 2816) < 2816) { W = p.in[14] + (size_t)DM * FFN2; K = 1024; N = FFN2; nblk = 176; WT = (bf16_t*)(ws + WS_WUP1); mode = 1; }
            else if ((r -= 2816) < 1408) { W = p.in[17]; K = FFN; N = 1024; nblk = 32; WT = (bf16_t*)(ws + WS_WDN0); }
            else { r -= 1408; W = p.in[17] + (size_t)FFN * DM; K = FFN; N = 1024; nblk = 32; WT = (bf16_t*)(ws + WS_WDN1); }
            const int kb = r / nblk, nb = r % nblk, n0 = nb * 32;
            int dst = n0;
            if (mode == 1) { const int bj = n0 / FFN, f = n0 % FFN; dst = 256 * (f / 128) + 128 * bj + (f % 128); }
            transpose_item(W, K, N, WT, dst, scr, kb * 64, n0, lane);
        }
    }
    for (int it = gw; it < 4096; it += NGW) {
        const int n0 = (it >> 5) * 8, k = (it & 31) * 64 + lane, h = k >> 7;
        const float* uv = p.in[11] + (size_t)k * 64;
        const float* wo = p.in[12] + (size_t)(h * 64) * DM + n0;
        float a[8];
#pragma unroll
        for (int i = 0; i < 8; ++i) a[i] = 0.f;
#pragma unroll 4
        for (int v4 = 0; v4 < 16; ++v4) { const f32x4 x = *(const f32x4*)(uv + v4 * 4);
#pragma unroll
            for (int j = 0; j < 4; ++j) { const f32x4 w0 = *(const f32x4*)(wo + (size_t)(v4 * 4 + j) * DM), w1 = *(const f32x4*)(wo + (size_t)(v4 * 4 + j) * DM + 4);
                a[0] += x[j] * w0[0]; a[1] += x[j] * w0[1]; a[2] += x[j] * w0[2]; a[3] += x[j] * w0[3];
                a[4] += x[j] * w1[0]; a[5] += x[j] * w1[1]; a[6] += x[j] * w1[2]; a[7] += x[j] * w1[3]; } }
        bf16_t* WT = (bf16_t*)(ws + WS_WDO);
#pragma unroll
        for (int i = 0; i < 8; ++i) WT[(size_t)(n0 + i) * 2048 + k] = (bf16_t)f2bf(a[i]);
    }
}

__device__ __forceinline__ void norm_phase(const float* src, const float* gain, const float* mod_l, int sh_off, int sc_off, bf16_t* dst) {
    const int tid = fresh_tid(), lane = tid & 63, gw = blockIdx.x * NWAVE + (tid >> 6), NGW = gridDim.x * NWAVE;
    const int rpw = (TOK + NGW - 1) / NGW, r0 = gw * rpw, r1 = (r0 + rpw < TOK) ? r0 + rpw : TOK;
    f32x4 cs[4], sh[4], vn[4]; int cur_b = -1;
    if (r0 < r1) { const f32x4* x0 = (const f32x4*)(src + (size_t)r0 * DM) + lane;
#pragma unroll
        for (int j = 0; j < 4; ++j) vn[j] = x0[64 * j]; }
    for (int row = r0; row < r1; ++row) {
        const int b = row >> 12;
        if (b != cur_b) { const float* mb = mod_l + (size_t)b * 6144;
#pragma unroll
            for (int j = 0; j < 4; ++j) { const int col = 4 * lane + 256 * j;
                cs[j] = *(const f32x4*)(gain + col) * (*(const f32x4*)(mb + sc_off + col) + 1.f); sh[j] = *(const f32x4*)(mb + sh_off + col); }
            cur_b = b; }
        f32x4 v[4]; float ss = 0.f;
#pragma unroll
        for (int j = 0; j < 4; ++j) v[j] = vn[j];
        if (row + 1 < r1) { const f32x4* xn = (const f32x4*)(src + (size_t)(row + 1) * DM) + lane;
#pragma unroll
            for (int j = 0; j < 4; ++j) vn[j] = xn[64 * j]; }
#pragma unroll
        for (int j = 0; j < 4; ++j) ss += (v[j].x * v[j].x + v[j].y * v[j].y) + (v[j].z * v[j].z + v[j].w * v[j].w);
        const float r = rsqrtf(wave_sum(ss) * (1.f / DM) + RMS_EPS);
        u32x2* o8 = (u32x2*)(dst + (size_t)row * DM) + lane;
#pragma unroll
        for (int j = 0; j < 4; ++j) { const f32x4 y = v[j] * r * cs[j] + sh[j];
            u32x2 o; o.x = pk2(y[0], y[1]); o.y = pk2(y[2], y[3]); o8[64 * j] = o; }
    }
}

__device__ __forceinline__ void fixup_phase(const float* hf, const float* hl, const float* cw, const float* cb, bf16_t* act) {
    const int gt = blockIdx.x * NTHR + fresh_tid(), NT = gridDim.x * NTHR;
    const f32x4 zero4 = (f32x4){0.f, 0.f, 0.f, 0.f};
    for (int e = gt; e < 512 * 2 * (FFN / 4); e += NT) {
        const int f = 4 * (e % (FFN / 4)), j = (e / (FFN / 4)) & 1, wb = e / (2 * (FFN / 4));
        const bool first = (wb & 63) == 0;
        f32x4 y[2];
#pragma unroll
        for (int part = 0; part < 2; ++part) {
            const int col = part * FFN + f;
            const f32x4 u0 = *(const f32x4*)(hf + (size_t)(wb * 2 + j) * FFN2 + col);
            const f32x4 lm1 = first ? zero4 : *(const f32x4*)(hl + (size_t)((wb - 1) * 2 + 1) * FFN2 + col);
            const f32x4 lm2 = first ? zero4 : *(const f32x4*)(hl + (size_t)((wb - 1) * 2 + 0) * FFN2 + col);
            const f32x4 u1 = j ? *(const f32x4*)(hf + (size_t)(wb * 2) * FFN2 + col) : lm1;
            const f32x4 u2 = j ? lm1 : lm2;
            y[part] = *(const f32x4*)(cb + col) + *(const f32x4*)(cw + col) * u2 + *(const f32x4*)(cw + FFN2 + col) * u1 + *(const f32x4*)(cw + 2 * FFN2 + col) * u0;
        }
        u32x2 o; o.x = pk2(silu_f(y[0][0]) * y[1][0], silu_f(y[0][1]) * y[1][1]); o.y = pk2(silu_f(y[0][2]) * y[1][2], silu_f(y[0][3]) * y[1][3]);
        *(u32x2*)(act + (size_t)(wb * 64 + j) * FFN + f) = o;
    }
}

__device__ __forceinline__ int crow(int r, int hi) { return (r & 3) + 8 * (r >> 2) + 4 * hi; }
__device__ __forceinline__ float other_half(float x) { const unsigned u = __builtin_bit_cast(unsigned, x); auto rr = __builtin_amdgcn_permlane32_swap(u, u, false, false);
    return __builtin_bit_cast(float, (unsigned)(rr[0] ^ rr[1] ^ u)); }
__device__ __forceinline__ void sb_qk(const LAS unsigned char* tb, const bf16x8 (&qr)[4], f32x16& p0, f32x16& p1, unsigned krd) {
    constexpr int KPITCH = 144;
    p0 = f32x16{}; p1 = f32x16{};
#pragma unroll
    for (int d0 = 0; d0 < 4; ++d0) {
        const bf16x8 a0 = *(const LAS bf16x8*)(tb + krd + d0 * 32);
        const bf16x8 a1 = *(const LAS bf16x8*)(tb + krd + 32 * KPITCH + d0 * 32);
        p0 = __builtin_amdgcn_mfma_f32_32x32x16_bf16(a0, qr[d0], p0, 0, 0, 0);
        p1 = __builtin_amdgcn_mfma_f32_32x32x16_bf16(a1, qr[d0], p1, 0, 0, 0);
    }
}
template <bool BAND> __device__ __forceinline__ void sb_sigma(f32x16& p0, f32x16& p1, int j, int t, int hi) {
#pragma unroll
    for (int r = 0; r < 16; ++r) {
        p0[r] = __builtin_amdgcn_rcpf(1.f + __builtin_amdgcn_exp2f(-p0[r]));
        p1[r] = __builtin_amdgcn_rcpf(1.f + __builtin_amdgcn_exp2f(-p1[r]));
    }
    if (BAND) {
#pragma unroll
        for (int r = 0; r < 16; ++r) { const int kv = 64 * j + crow(r, hi); if (kv >= t) p0[r] = 0.f; if (kv + 32 >= t) p1[r] = 0.f; }
    }
}
__device__ __forceinline__ void sb_local(f32x16& p, float (&G)[4]) {
#pragma unroll
    for (int g = 0; g < 4; ++g) {
        const float k0 = 1.f - p[4 * g], k1 = 1.f - p[4 * g + 1], k2 = 1.f - p[4 * g + 2], k3 = 1.f - p[4 * g + 3];
        const float s2 = k3, s1 = k3 * k2, s0 = s1 * k1;
        p[4 * g + 2] *= s2; p[4 * g + 1] *= s1; p[4 * g] *= s0; G[g] = s0 * k0;
    }
}
__device__ __forceinline__ void sb_chain(const float (&G1)[4], const float (&G0)[4], float& acc, float (&mine1)[4], float (&mine0)[4], int r32, int hi) {
#pragma unroll
    for (int g = 3; g >= 0; --g) {
        const float gl = __shfl(G1[g], r32), gh = __shfl(G1[g], r32 + 32);
        const float m1 = acc; acc *= gh; const float m0 = acc; acc *= gl; mine1[g] = hi ? m1 : m0;
    }
#pragma unroll
    for (int g = 3; g >= 0; --g) {
        const float gl = __shfl(G0[g], r32), gh = __shfl(G0[g], r32 + 32);
        const float m1 = acc; acc *= gh; const float m0 = acc; acc *= gl; mine0[g] = hi ? m1 : m0;
    }
}
__device__ __forceinline__ void sb_pv(const LAS unsigned char* tb, const f32x16& p0, const f32x16& p1, const float (&mine0)[4], const float (&mine1)[4], f32x16 (&o)[2], unsigned vrd) {
#pragma unroll
    for (int X = 1; X >= 0; --X)
#pragma unroll
        for (int s = 0; s < 2; ++s) {
            u32x4 pw;
#define AV(i) (X == 0 ? p0[8 * s + (i)] * mine0[(8 * s + (i)) >> 2] : p1[8 * s + (i)] * mine1[(8 * s + (i)) >> 2])
            pw.x = pg8::cvt_pk_bf16(AV(0), AV(1)); pw.y = pg8::cvt_pk_bf16(AV(2), AV(3)); pw.z = pg8::cvt_pk_bf16(AV(4), AV(5)); pw.w = pg8::cvt_pk_bf16(AV(6), AV(7));
#undef AV
            const bf16x8 pf = __builtin_bit_cast(bf16x8, pw);
#pragma unroll
            for (int c = 0; c < 2; ++c) {
                const LAS unsigned char* vp = tb + vrd + ((8 * X + 4 * s) * 4 + 2 * c) * 128;
                const s16x4 lo = __builtin_bit_cast(s16x4, __builtin_amdgcn_ds_read_tr16_b64_v4i16((LAS s16x4*)(vp)));
                const s16x4 hh = __builtin_bit_cast(s16x4, __builtin_amdgcn_ds_read_tr16_b64_v4i16((LAS s16x4*)(vp + 2 * 4 * 128)));
                const bf16x8 vf = (bf16x8){lo[0], lo[1], lo[2], lo[3], hh[0], hh[1], hh[2], hh[3]};
                o[c] = __builtin_amdgcn_mfma_f32_32x32x16_bf16(vf, pf, o[c], 0, 0, 0);
            }
        }
}
__device__ __forceinline__ void sb_tile(const LAS unsigned char* tb, int j, const bf16x8 (&qr)[4], f32x16 (&o)[2], float& Rp, int t, int tq0, int r32, int hi, unsigned krd, unsigned vrd) {
    if (!(64 * j < tq0 + 31)) return;
    if (__all(Rp == 0.f)) return;
    f32x16 p0, p1; float G0[4], G1[4], mine0[4], mine1[4];
    sb_qk(tb, qr, p0, p1, krd);
    if (64 * j + 63 >= tq0) sb_sigma<true>(p0, p1, j, t, hi); else sb_sigma<false>(p0, p1, j, t, hi);
    sb_local(p0, G0); sb_local(p1, G1);
    sb_chain(G1, G0, Rp, mine1, mine0, r32, hi);
    sb_pv(tb, p0, p1, mine0, mine1, o, vrd);
}
__device__ __forceinline__ void sb_tile2(const LAS unsigned char* tbA, const LAS unsigned char* tbB, const bf16x8 (&qr)[4], f32x16 (&o)[2], float& Rp, int r32, int hi, unsigned krd, unsigned vrd) {
    if (__all(Rp == 0.f)) return;
    f32x16 a0, a1, b0, b1; float GA0[4], GA1[4], GB0[4], GB1[4], mA0[4], mA1[4], mB0[4], mB1[4];
    sb_qk(tbA, qr, a0, a1, krd);
    sb_qk(tbB, qr, b0, b1, krd);
    sb_sigma<false>(a0, a1, 0, 0, hi);
    sb_local(a0, GA0); sb_local(a1, GA1);
    sb_chain(GA1, GA0, Rp, mA1, mA0, r32, hi);
    sb_sigma<false>(b0, b1, 0, 0, hi);
    sb_pv(tbA, a0, a1, mA0, mA1, o, vrd);
    sb_local(b0, GB0); sb_local(b1, GB1);
    sb_chain(GB1, GB0, Rp, mB1, mB0, r32, hi);
    sb_pv(tbB, b0, b1, mB0, mB1, o, vrd);
}
__device__ __forceinline__ void sb_attn_phase(const bf16_t* Q, const bf16_t* K, const bf16_t* V, bf16_t* O, LAS unsigned char* lds) {
    constexpr int KPITCH = 144, KBYTES = 64 * KPITCH, BUFB = KBYTES + 8192;
    const int tid = fresh_tid(), lane = tid & 63, r32 = lane & 31, hi = lane >> 5;
    const int wid = __builtin_amdgcn_readfirstlane(tid >> 6);
    const int kv_s = tid >> 3, d8 = tid & 7;
    const unsigned kst = kv_s * KPITCH + d8 * 16;
    const unsigned vst = KBYTES + ((kv_s >> 2) * 4 + (d8 >> 1)) * 128 + (kv_s & 3) * 32 + (d8 & 1) * 16;
    const unsigned vrd = KBYTES + (hi * 4 + ((lane >> 4) & 1)) * 128 + ((lane & 15) >> 2) * 32 + (lane & 3) * 8;
    const unsigned krd = r32 * KPITCH + hi * 16;
    LAS unsigned* votes = (LAS unsigned*)(lds + 4 * BUFB);
    for (int pi = blockIdx.x; pi < 1024; pi += gridDim.x) {
#pragma unroll 1
        for (int half = 0; half < 2; ++half) {
            const int bh = pi >> 3, sidx = pi & 7, qb = half ? 15 - sidx : sidx;
            const int b = bh >> 4, h = bh & 15;
            const size_t rowbase = (size_t)b * SEQ;
            const int q0 = qb * 256, tq0 = q0 + 32 * wid, t = tq0 + r32;
            const int NP = 2 * (qb + 1);
            bf16x8 qr[4];
#pragma unroll
            for (int d0 = 0; d0 < 4; ++d0) qr[d0] = *(const bf16x8*)(Q + (rowbase + t) * DM + h * 64 + d0 * 16 + hi * 8);
            f32x16 o[2]; o[0] = f32x16{}; o[1] = f32x16{};
            float Rp = 1.f;
            const bf16_t* Kg = K + (rowbase + kv_s) * DM + h * 64 + d8 * 8;
            const bf16_t* Vg = V + (rowbase + kv_s) * DM + h * 64 + d8 * 8;
            u32x4 kreg[2], vreg[2];
#pragma unroll
            for (int s = 0; s < 2; ++s) { kreg[s] = *(const u32x4*)(Kg + (size_t)(2 * (NP - 1) + s) * 64 * DM); vreg[s] = *(const u32x4*)(Vg + (size_t)(2 * (NP - 1) + s) * 64 * DM); }
#pragma unroll
            for (int s = 0; s < 2; ++s) { *(LAS u32x4*)(lds + s * BUFB + kst) = kreg[s]; *(LAS u32x4*)(lds + s * BUFB + vst) = vreg[s]; }
            __syncthreads();
            int cur = 0;
#pragma unroll 1
            for (int jp = NP - 1; jp >= 0; --jp) {
                if (jp > 0) {
#pragma unroll
                    for (int s = 0; s < 2; ++s) { kreg[s] = *(const u32x4*)(Kg + (size_t)(2 * (jp - 1) + s) * 64 * DM); vreg[s] = *(const u32x4*)(Vg + (size_t)(2 * (jp - 1) + s) * 64 * DM); }
                }
                const LAS unsigned char* tb = lds + cur * 2 * BUFB;
                if (64 * (2 * jp + 1) + 63 < tq0) sb_tile2(tb + BUFB, tb, qr, o, Rp, r32, hi, krd, vrd);
                else { sb_tile(tb + BUFB, 2 * jp + 1, qr, o, Rp, t, tq0, r32, hi, krd, vrd); sb_tile(tb, 2 * jp, qr, o, Rp, t, tq0, r32, hi, krd, vrd); }
                if (jp > 0) {
#pragma unroll
                    for (int s = 0; s < 2; ++s) { *(LAS u32x4*)(lds + ((cur ^ 1) * 2 + s) * BUFB + kst) = kreg[s]; *(LAS u32x4*)(lds + ((cur ^ 1) * 2 + s) * BUFB + vst) = vreg[s]; }
                }
                if (lane == 0) votes[cur * 8 + wid] = __all(Rp == 0.f) ? 1u : 0u;
                __syncthreads();
                { const u32x4 v0 = *(const LAS u32x4*)(votes + cur * 8), v1 = *(const LAS u32x4*)(votes + cur * 8 + 4);
                  if ((v0.x & v0.y & v0.z & v0.w & v1.x & v1.y & v1.z & v1.w) != 0u) break; }
                cur ^= 1;
            }
            __syncthreads();
            { LAS unsigned char* stg = lds + 73728 + wid * 4352;
#pragma unroll
              for (int c = 0; c < 2; ++c)
#pragma unroll
                for (int g = 0; g < 4; ++g) { u32x2 w; w.x = pg8::cvt_pk_bf16(o[c][4 * g], o[c][4 * g + 1]); w.y = pg8::cvt_pk_bf16(o[c][4 * g + 2], o[c][4 * g + 3]);
                    *(LAS u32x2*)(stg + r32 * 136 + 64 * c + 16 * g + 8 * hi) = w; }
              LDS_WAIT();
              bf16_t* Ob = O + (rowbase + tq0) * DM + h * 64;
#pragma unroll
              for (int k = 0; k < 4; ++k) { const int pc = lane + 64 * k, rw = pc >> 3, pp = pc & 7;
                  const u32x2 v0 = *(const LAS u32x2*)(stg + rw * 136 + pp * 16), v1 = *(const LAS u32x2*)(stg + rw * 136 + pp * 16 + 8);
                  *(u32x4*)(Ob + (size_t)rw * DM + pp * 8) = (u32x4){v0.x, v0.y, v1.x, v1.y}; }
              LDS_WAIT(); }
        }
    }
}

__device__ __forceinline__ unsigned sortkey(float v) { const unsigned u = __builtin_bit_cast(unsigned, v + 0.f);
    return (u & 0x80000000u) ? ~u : (u | 0x80000000u); }
__device__ __forceinline__ void indexer_phase(const bf16_t* PJ, float* rk, unsigned short* SEL, LAS unsigned char* lds) {
    const int tid = fresh_tid(), lane = tid & 63, r32 = lane & 31, hi = lane >> 5;
    const int wid = __builtin_amdgcn_readfirstlane(tid >> 6);
    { const int gw = blockIdx.x * NWAVE + wid, NGW = gridDim.x * NWAVE;
      for (int t4 = gw; t4 < TOK / 4; t4 += NGW) { const int tok = 4 * t4 + (lane >> 4);
          const u32x4 w = *(const u32x4*)(PJ + (size_t)tok * PROJ_LD + PJ_LAT + 8 * (lane & 15));
          float ss = bflo(w.x) * bflo(w.x) + bfhi(w.x) * bfhi(w.x) + bflo(w.y) * bflo(w.y) + bfhi(w.y) * bfhi(w.y) + bflo(w.z) * bflo(w.z) + bfhi(w.z) * bfhi(w.z) + bflo(w.w) * bflo(w.w) + bfhi(w.w) * bfhi(w.w);
          ss += __shfl_xor(ss, 1); ss += __shfl_xor(ss, 2); ss += __shfl_xor(ss, 4); ss += __shfl_xor(ss, 8);
          if ((lane & 15) == 0) rk[tok] = rsqrtf(ss * (1.f / 128.f) + RMS_EPS); } }
    constexpr int AUX0 = 131072, AUXW = 3072;
    LAS unsigned* hist = (LAS unsigned*)(lds + AUX0 + wid * AUXW);
    LAS unsigned short* listA = (LAS unsigned short*)(lds + AUX0 + wid * AUXW + 2080);
    LAS float* pmm = (LAS float*)(lds + AUX0 + NWAVE * AUXW);
    for (int gl = blockIdx.x; gl < TOK / 8; gl += gridDim.x) {
        const int b = gl >> 9, jj = gl & 511, t0 = (jj < 256 ? jj : 767 - jj) * 8;
        const size_t rowbase = (size_t)b * SEQ;
        const int t = t0 + wid;
        unsigned short* selrow = SEL + (rowbase + t) * 256;
        if (t0 + 7 < 256) {
#pragma unroll
            for (int i = 0; i < 4; ++i) { const int s = lane + 64 * i; selrow[s] = (unsigned short)(s <= t ? s : 0); }
            continue;
        }
        {
            const int g = r32 >> 3, hp = (r32 >> 2) & 1, ii = r32 & 3, tq = 2 * hp + (g >> 1), head = 4 * (g & 1) + ii;
            bf16x8 af[2][4]; float wq[2][2][8];
#pragma unroll
            for (int rt = 0; rt < 2; ++rt) {
                const bf16_t* qp = PJ + (rowbase + t0 + 4 * rt + tq) * PROJ_LD + PJ_QI + head * 64 + hi * 8;
#pragma unroll
                for (int kk = 0; kk < 4; ++kk) af[rt][kk] = *(const bf16x8*)(qp + kk * 16);
#pragma unroll
                for (int qq = 0; qq < 2; ++qq) { const u32x4 w = *(const u32x4*)(PJ + (rowbase + t0 + 4 * rt + 2 * hi + qq) * PROJ_LD + PJ_WI);
                    const float sc = 0.35355339059327373f;
                    wq[rt][qq][0] = bflo(w.x) * sc; wq[rt][qq][1] = bfhi(w.x) * sc; wq[rt][qq][2] = bflo(w.y) * sc; wq[rt][qq][3] = bfhi(w.y) * sc;
                    wq[rt][qq][4] = bflo(w.z) * sc; wq[rt][qq][5] = bfhi(w.z) * sc; wq[rt][qq][6] = bflo(w.w) * sc; wq[rt][qq][7] = bfhi(w.w) * sc; }
            }
            float rmax[2][2], rmin[2][2];
#pragma unroll
            for (int rt = 0; rt < 2; ++rt)
#pragma unroll
                for (int qq = 0; qq < 2; ++qq) { rmax[rt][qq] = -INFINITY; rmin[rt][qq] = INFINITY; }
            const int nkt = (t0 + 8 + 31) >> 5;
            const bf16_t* kbase = PJ + (rowbase + r32) * PROJ_LD + PJ_KI + hi * 8;
            bf16x8 bcur[4], bnxt[4];
            int kt = wid;
#pragma unroll
            for (int kk = 0; kk < 4; ++kk) bcur[kk] = *(const bf16x8*)(kbase + (size_t)(32 * kt) * PROJ_LD + kk * 16);
#pragma unroll 1
            while (kt < nkt) {
                const int kn = kt + NWAVE;
                if (kn < nkt) {
#pragma unroll
                    for (int kk = 0; kk < 4; ++kk) bnxt[kk] = *(const bf16x8*)(kbase + (size_t)(32 * kn) * PROJ_LD + kk * 16);
                }
                const int key = 32 * kt + r32;
#pragma unroll
                for (int rt = 0; rt < 2; ++rt) {
                    f32x16 acc = f32x16{};
#pragma unroll
                    for (int kk = 0; kk < 4; ++kk) acc = __builtin_amdgcn_mfma_f32_32x32x16_bf16(af[rt][kk], bcur[kk], acc, 0, 0, 0);
#pragma unroll
                    for (int qq = 0; qq < 2; ++qq) { float s = 0.f;
#pragma unroll
                        for (int e = 0; e < 8; ++e) s += wq[rt][qq][e] * fmaxf(acc[8 * qq + e], 0.f);
                        ((LAS float*)lds)[(4 * rt + 2 * hi + qq) * 4096 + key] = s;
                        const bool ok = key <= t0 + 4 * rt + 2 * hi + qq;
                        rmax[rt][qq] = fmaxf(rmax[rt][qq], ok ? s : -INFINITY); rmin[rt][qq] = fminf(rmin[rt][qq], ok ? s : INFINITY); }
                }
#pragma unroll
                for (int kk = 0; kk < 4; ++kk) bcur[kk] = bnxt[kk];
                kt = kn;
            }
#pragma unroll
            for (int rt = 0; rt < 2; ++rt)
#pragma unroll
                for (int qq = 0; qq < 2; ++qq) {
#pragma unroll
                    for (int o = 1; o < 32; o <<= 1) { rmax[rt][qq] = fmaxf(rmax[rt][qq], __shfl_xor(rmax[rt][qq], o)); rmin[rt][qq] = fminf(rmin[rt][qq], __shfl_xor(rmin[rt][qq], o)); }
                    if (r32 == 0) { pmm[(wid * 8 + 4 * rt + 2 * hi + qq) * 2] = rmax[rt][qq]; pmm[(wid * 8 + 4 * rt + 2 * hi + qq) * 2 + 1] = rmin[rt][qq]; } }
        }
        __syncthreads();
        {
            const LAS float* row = (const LAS float*)lds + wid * 4096;
            float vmax = -INFINITY, vmin = INFINITY;
#pragma unroll
            for (int w = 0; w < NWAVE; ++w) { vmax = fmaxf(vmax, pmm[(w * 8 + wid) * 2]); vmin = fminf(vmin, pmm[(w * 8 + wid) * 2 + 1]); }
            const int nI4 = (t >> 8) + 1;
            float lo = vmin, sc = (vmax > vmin) ? 511.f / (vmax - vmin) : 0.f;
            float lo0 = 0.f, sc0 = 0.f, lo1 = 0.f, sc1 = 0.f; int b0 = 0, b1 = 0;
            unsigned need = 256u, base = 0u;
            bool by_index = false;
            LAS unsigned* cl = hist;
#define BINL(x, l, s) min((int)(((x) - (l)) * (s)), 511)
#define ACTIVE(x, idx) (((idx) <= t) & ((lev < 1) | (BINL(x, lo0, sc0) == b0)) & ((lev < 2) | (BINL(x, lo1, sc1) == b1)))
#pragma unroll 1
            for (int lev = 0; ; ++lev) {
#pragma unroll
                for (int i = 0; i < 9; ++i) if (lane + 64 * i < 520) hist[lane + 64 * i] = 0u;
                if (lev == 0) {
#pragma unroll 2
                    for (int i = 0; i < nI4; ++i) { const f32x4 x4 = *(const LAS f32x4*)(row + 256 * i + 4 * lane);
#pragma unroll
                        for (int e = 0; e < 4; ++e) { const int idx = 256 * i + 4 * lane + e; const int bn = (idx <= t) ? BINL(x4[e], lo, sc) : 512 + (lane & 7);
                            __hip_atomic_fetch_add(hist + bn, 1u, __ATOMIC_RELAXED, __HIP_MEMORY_SCOPE_WORKGROUP); } }
                } else {
#pragma unroll 2
                for (int i = 0; i < nI4; ++i) { const f32x4 x4 = *(const LAS f32x4*)(row + 256 * i + 4 * lane);
#pragma unroll
                    for (int e = 0; e < 4; ++e) { const int idx = 256 * i + 4 * lane + e; const float ve = by_index ? -(float)idx : x4[e]; const int bn = ACTIVE(x4[e], idx) ? BINL(ve, lo, sc) : 512 + (lane & 7);
                        __hip_atomic_fetch_add(hist + bn, 1u, __ATOMIC_RELAXED, __HIP_MEMORY_SCOPE_WORKGROUP); } }
                }
                LDS_WAIT();
                unsigned c[8]; unsigned lsum = 0;
                { const u32x4 h0 = *(const LAS u32x4*)(hist + 8 * lane), h1 = *(const LAS u32x4*)(hist + 8 * lane + 4);
                  c[0] = h0.x; c[1] = h0.y; c[2] = h0.z; c[3] = h0.w; c[4] = h1.x; c[5] = h1.y; c[6] = h1.z; c[7] = h1.w; }
#pragma unroll
                for (int i = 0; i < 8; ++i) lsum += c[i];
                unsigned sfx = lsum;
#pragma unroll
                for (int o = 1; o < 64; o <<= 1) { const unsigned x = __shfl_down(sfx, o); if (lane + o < 64) sfx += x; }
                unsigned cum = sfx - lsum; int bst = -1; unsigned cab = 0, ceq = 0;
#pragma unroll
                for (int i = 7; i >= 0; --i) { if (cum < need && cum + c[i] >= need) { bst = 8 * lane + i; cab = cum; ceq = c[i]; } cum += c[i]; }
                const unsigned long long bm = __ballot(bst >= 0);
                const int src = __builtin_amdgcn_readfirstlane((int)__builtin_ctzll(bm));
                const int bstar = __builtin_amdgcn_readfirstlane(__shfl(bst, src));
                const unsigned cnt_above = (unsigned)__builtin_amdgcn_readfirstlane((int)__shfl(cab, src)), cnt_eq = (unsigned)__builtin_amdgcn_readfirstlane((int)__shfl(ceq, src));
                need -= cnt_above;
                LDS_WAIT();
                const bool fast = cnt_eq <= 64u;
                unsigned cb2 = 0; float amax = -INFINITY, amin = INFINITY;
                if (lev == 0) {
#pragma unroll 1
                for (int i = 0; i < nI4; ++i) { const f32x4 x4 = *(const LAS f32x4*)(row + 256 * i + 4 * lane);
                    const int idx0 = 256 * i + 4 * lane;
                    bool sv[4], ev[4]; float vv[4]; unsigned ns = 0;
#pragma unroll
                    for (int e = 0; e < 4; ++e) { const int idx = idx0 + e; const bool act = idx <= t; vv[e] = x4[e]; const int bn = BINL(vv[e], lo, sc);
                        sv[e] = act & (bn > bstar); ev[e] = act & (bn == bstar); ns += sv[e] ? 1u : 0u; }
                    const unsigned long long m1 = __ballot(ns & 1u), m2 = __ballot(ns & 2u), m4 = __ballot(ns & 4u);
                    unsigned pos = base + __builtin_amdgcn_mbcnt_hi((unsigned)(m1 >> 32), __builtin_amdgcn_mbcnt_lo((unsigned)m1, 0u))
                                        + 2u * __builtin_amdgcn_mbcnt_hi((unsigned)(m2 >> 32), __builtin_amdgcn_mbcnt_lo((unsigned)m2, 0u))
                                        + 4u * __builtin_amdgcn_mbcnt_hi((unsigned)(m4 >> 32), __builtin_amdgcn_mbcnt_lo((unsigned)m4, 0u));
                    base += (unsigned)__builtin_popcountll(m1) + 2u * (unsigned)__builtin_popcountll(m2) + 4u * (unsigned)__builtin_popcountll(m4);
#pragma unroll
                    for (int e = 0; e < 4; ++e) { listA[sv[e] ? pos : 256u + (unsigned)lane] = (unsigned short)(idx0 + e); pos += sv[e] ? 1u : 0u; }
                    const bool anye = ev[0] | ev[1] | ev[2] | ev[3];
                    if (fast) {
                        if (__ballot(anye) != 0ull) {
#pragma unroll
                            for (int e = 0; e < 4; ++e) { const unsigned long long me = __ballot(ev[e]);
                                if (ev[e]) { const unsigned cp = cb2 + __builtin_amdgcn_mbcnt_hi((unsigned)(me >> 32), __builtin_amdgcn_mbcnt_lo((unsigned)me, 0u)); cl[cp] = (unsigned)(idx0 + e); cl[64 + cp] = __builtin_bit_cast(unsigned, vv[e]); }
                                cb2 += (unsigned)__builtin_popcountll(me); } }
                    } else {
#pragma unroll
                        for (int e = 0; e < 4; ++e) { amax = fmaxf(amax, ev[e] ? vv[e] : -INFINITY); amin = fminf(amin, ev[e] ? vv[e] : INFINITY); }
                    } }
                } else {
#pragma unroll 1
                for (int i = 0; i < nI4; ++i) { const f32x4 x4 = *(const LAS f32x4*)(row + 256 * i + 4 * lane);
                    const int idx0 = 256 * i + 4 * lane;
                    bool sv[4], ev[4]; float vv[4]; unsigned ns = 0;
#pragma unroll
                    for (int e = 0; e < 4; ++e) { const int idx = idx0 + e; const bool act = ACTIVE(x4[e], idx); vv[e] = by_index ? -(float)idx : x4[e]; const int bn = BINL(vv[e], lo, sc);
                        sv[e] = act & (bn > bstar); ev[e] = act & (bn == bstar); ns += sv[e] ? 1u : 0u; }
                    const unsigned long long m1 = __ballot(ns & 1u), m2 = __ballot(ns & 2u), m4 = __ballot(ns & 4u);
                    unsigned pos = base + __builtin_amdgcn_mbcnt_hi((unsigned)(m1 >> 32), __builtin_amdgcn_mbcnt_lo((unsigned)m1, 0u))
                                        + 2u * __builtin_amdgcn_mbcnt_hi((unsigned)(m2 >> 32), __builtin_amdgcn_mbcnt_lo((unsigned)m2, 0u))
                                        + 4u * __builtin_amdgcn_mbcnt_hi((unsigned)(m4 >> 32), __builtin_amdgcn_mbcnt_lo((unsigned)m4, 0u));
                    base += (unsigned)__builtin_popcountll(m1) + 2u * (unsigned)__builtin_popcountll(m2) + 4u * (unsigned)__builtin_popcountll(m4);
#pragma unroll
                    for (int e = 0; e < 4; ++e) { listA[sv[e] ? pos : 256u + (unsigned)lane] = (unsigned short)(idx0 + e); pos += sv[e] ? 1u : 0u; }
                    const bool anye = ev[0] | ev[1] | ev[2] | ev[3];
                    if (fast) {
                        if (__ballot(anye) != 0ull) {
#pragma unroll
                            for (int e = 0; e < 4; ++e) { const unsigned long long me = __ballot(ev[e]);
                                if (ev[e]) { const unsigned cp = cb2 + __builtin_amdgcn_mbcnt_hi((unsigned)(me >> 32), __builtin_amdgcn_mbcnt_lo((unsigned)me, 0u)); cl[cp] = (unsigned)(idx0 + e); cl[64 + cp] = __builtin_bit_cast(unsigned, vv[e]); }
                                cb2 += (unsigned)__builtin_popcountll(me); } }
                    } else {
#pragma unroll
                        for (int e = 0; e < 4; ++e) { amax = fmaxf(amax, ev[e] ? vv[e] : -INFINITY); amin = fminf(amin, ev[e] ? vv[e] : INFINITY); }
                    } }
                }
                if (fast) {
                    LDS_WAIT();
                    const bool have = (unsigned)lane < cnt_eq;
                    const unsigned myi = have ? cl[lane] : 0xffffffffu; const float myv = have ? __builtin_bit_cast(float, cl[64 + lane]) : -INFINITY;
                    unsigned rank = 0;
                    for (unsigned j2 = 0; j2 < cnt_eq; ++j2) { const float vj = __shfl(myv, (int)j2); const unsigned ij = __shfl(myi, (int)j2); rank += (vj > myv || (vj == myv && ij < myi)) ? 1u : 0u; }
                    const bool s = have && rank < need; const unsigned long long m = __ballot(s);
                    if (s) listA[base + __builtin_amdgcn_mbcnt_hi((unsigned)(m >> 32), __builtin_amdgcn_mbcnt_lo((unsigned)m, 0u))] = (unsigned short)myi;
                    break;
                }
#pragma unroll
                for (int o = 1; o < 64; o <<= 1) { amax = fmaxf(amax, __shfl_xor(amax, o)); amin = fminf(amin, __shfl_xor(amin, o)); }
                if (lev < 2 && !by_index) {
                    if (lev == 0) { lo0 = lo; sc0 = sc; b0 = bstar; } else { lo1 = lo; sc1 = sc; b1 = bstar; }
                    if (amax > amin) { lo = amin; sc = 511.f / (amax - amin); }
                    else { by_index = true; lo = -(float)t; sc = 511.f / (float)t; }
                    continue;
                }
                {
                    const int nI = (t >> 6) + 1;
                    const unsigned kmin = sortkey(amin), kmax = sortkey(amax), kdiff = kmin ^ kmax; const int nb = kdiff ? 32 - __builtin_clz(kdiff) : 0;
                    unsigned tau = nb >= 32 ? 0u : ((kmax >> nb) << nb);
#define CAND(x, idx) (ACTIVE(x, idx) && BINL(x, lo, sc) == bstar)
#pragma unroll 1
                    for (int bit = nb - 1; bit >= 0; --bit) { const unsigned trial = tau | (1u << bit); unsigned cnt = 0;
#pragma unroll 2
                        for (int i = 0; i < nI; ++i) { const int idx = lane + 64 * i; const float x = row[idx]; cnt += (CAND(x, idx) && sortkey(x) >= trial) ? 1u : 0u; }
#pragma unroll
                        for (int o = 1; o < 64; o <<= 1) cnt += __shfl_xor(cnt, o);
                        if (cnt >= need) tau = trial; }
                    unsigned cg = 0;
#pragma unroll 2
                    for (int i = 0; i < nI; ++i) { const int idx = lane + 64 * i; const float x = row[idx]; cg += (CAND(x, idx) && sortkey(x) > tau) ? 1u : 0u; }
#pragma unroll
                    for (int o = 1; o < 64; o <<= 1) cg += __shfl_xor(cg, o);
                    unsigned ties = need - cg;
#pragma unroll 1
                    for (int i = 0; i < nI; ++i) { const int idx = lane + 64 * i; const float x = row[idx]; const bool cand = CAND(x, idx); const unsigned kx = sortkey(x);
                        const bool gt = cand && kx > tau, eq = cand && kx == tau; const unsigned long long me = __ballot(eq);
                        const unsigned eoff = __builtin_amdgcn_mbcnt_hi((unsigned)(me >> 32), __builtin_amdgcn_mbcnt_lo((unsigned)me, 0u));
                        const bool s = gt || (eq && eoff < ties); const unsigned long long m = __ballot(s);
                        if (s) listA[base + __builtin_amdgcn_mbcnt_hi((unsigned)(m >> 32), __builtin_amdgcn_mbcnt_lo((unsigned)m, 0u))] = (unsigned short)idx;
                        base += (unsigned)__builtin_popcountll(m); const unsigned ne = (unsigned)__builtin_popcountll(me); ties = ties > ne ? ties - ne : 0u; }
#undef CAND
                    break;
                }
            }
#undef ACTIVE
#undef BINL
            LDS_WAIT();
            *(u32x2*)(selrow + 4 * lane) = *(const LAS u32x2*)(listA + 4 * lane);
        }
        __syncthreads();
    }
}

__device__ __forceinline__ unsigned off_b(unsigned row, unsigned ch) { return 256u * row + 16u * (ch ^ (((row & 3) << 2) | ((row >> 2) & 3))); }
__device__ __forceinline__ void dsa_attn_phase(const bf16_t* PJ, const float* rk, const unsigned short* SEL, const float* biasd, const float* qg, const float* kg, bf16_t* OL, LAS unsigned char* lds) {
    const int tid = fresh_tid(), lane = tid & 63, c16 = lane & 15, G = lane >> 4;
    const int wid = __builtin_amdgcn_readfirstlane(tid >> 6);
    LAS float* biasS = (LAS float*)(lds + 135168);
    for (int e = tid; e < 2048; e += NTHR) biasS[e] = biasd[e];
    if (tid < 16) biasS[2048 + tid] = -INFINITY;
    __syncthreads();
    LAS unsigned char* tile = lds + wid * 16896;
    LAS int* selS = (LAS int*)(tile + 16384);
    LAS float* rS = (LAS float*)(tile + 16384 + 256);
    const int gw = blockIdx.x * NWAVE + wid, NGW = gridDim.x * NWAVE;
    float bmax = -INFINITY;
#pragma unroll 4
    for (int d = G * 32; d < G * 32 + 32; ++d) bmax = fmaxf(bmax, biasS[d * 16 + c16]);
    bmax = fmaxf(bmax, __shfl_xor(bmax, 16)); bmax = fmaxf(bmax, __shfl_xor(bmax, 32));
    u32x4 selreg = (u32x4){0u, 0u, 0u, 0u};
    if (gw < TOK) { const unsigned short* sp = SEL + (size_t)gw * 256 + lane; selreg = (u32x4){sp[0], sp[64], sp[128], sp[192]}; }
#pragma unroll 1
    for (int qi = gw; qi < TOK; qi += NGW) {
        const int b = qi >> 12, t = qi & 4095;
        const size_t rowbase = (size_t)b * SEQ;
        const int count = (t + 1 < 256) ? t + 1 : 256;
        const int nch = (count + 63) >> 6;
        const bf16_t* latb = PJ + rowbase * PROJ_LD + PJ_LAT + c16 * 8;
        int sl = (lane < count) ? (int)selreg[0] : 0;
        float rkv = rk[rowbase + sl];
        u32x4 gr[16];
#pragma unroll
        for (int i = 0; i < 16; ++i) { const int srow = __shfl(sl, 4 * i + G); gr[i] = *(const u32x4*)(latb + (size_t)srow * PROJ_LD); }
        bf16x8 qf[4]; float mshift;
        {
            float qv[4][8]; float ss = 0.f;
#pragma unroll
            for (int kk = 0; kk < 4; ++kk) { const u32x4 w = *(const u32x4*)(PJ + (rowbase + t) * PROJ_LD + c16 * 128 + 32 * kk + 8 * G);
                qv[kk][0] = bflo(w.x); qv[kk][1] = bfhi(w.x); qv[kk][2] = bflo(w.y); qv[kk][3] = bfhi(w.y); qv[kk][4] = bflo(w.z); qv[kk][5] = bfhi(w.z); qv[kk][6] = bflo(w.w); qv[kk][7] = bfhi(w.w);
#pragma unroll
                for (int j = 0; j < 8; ++j) ss += qv[kk][j] * qv[kk][j]; }
            ss += __shfl_xor(ss, 16); ss += __shfl_xor(ss, 32);
            const float rinv = rsqrtf(ss * (1.f / 128.f) + RMS_EPS) * (0.08838834764831845f * LOG2E);
            float qn = 0.f;
#pragma unroll
            for (int kk = 0; kk < 4; ++kk) { const int d = 32 * kk + 8 * G;
                const f32x4 g0 = *(const f32x4*)(qg + d), g1 = *(const f32x4*)(qg + d + 4), h0 = *(const f32x4*)(kg + d), h1 = *(const f32x4*)(kg + d + 4);
                u32x4 w; w.x = pg8::cvt_pk_bf16(qv[kk][0] * rinv * g0[0] * h0[0], qv[kk][1] * rinv * g0[1] * h0[1]); w.y = pg8::cvt_pk_bf16(qv[kk][2] * rinv * g0[2] * h0[2], qv[kk][3] * rinv * g0[3] * h0[3]);
                w.z = pg8::cvt_pk_bf16(qv[kk][4] * rinv * g1[0] * h1[0], qv[kk][5] * rinv * g1[1] * h1[1]); w.w = pg8::cvt_pk_bf16(qv[kk][6] * rinv * g1[2] * h1[2], qv[kk][7] * rinv * g1[3] * h1[3]);
                qf[kk] = __builtin_bit_cast(bf16x8, w);
                qn += bflo(w.x) * bflo(w.x) + bfhi(w.x) * bfhi(w.x) + bflo(w.y) * bflo(w.y) + bfhi(w.y) * bfhi(w.y) + bflo(w.z) * bflo(w.z) + bfhi(w.z) * bfhi(w.z) + bflo(w.w) * bflo(w.w) + bfhi(w.w) * bfhi(w.w); }
            qn += __shfl_xor(qn, 16); qn += __shfl_xor(qn, 32);
            mshift = sqrtf(qn) * 11.313708498984761f * 1.01f + bmax;
        }
        f32x4 o[8];
#pragma unroll
        for (int dt = 0; dt < 8; ++dt) o[dt] = (f32x4){0.f, 0.f, 0.f, 0.f};
        float lrun = 0.f;
        u32x4 selnext = selreg;
#pragma unroll 1
        for (int ch = 0; ch < nch; ++ch) {
            { const bool vk = ch * 64 + lane < count; int dist = t - sl; dist = dist < 0 ? 0 : (dist > 127 ? 127 : dist);
              selS[lane] = vk ? dist * 16 : 2048; rS[lane] = vk ? rkv : 0.f; }
#pragma unroll
            for (int i = 0; i < 16; ++i) *(LAS u32x4*)(tile + off_b(4 * i + G, c16)) = gr[i];
            if (ch + 1 < nch) {
                const unsigned sv = (ch == 0) ? selreg[1] : (ch == 1) ? selreg[2] : selreg[3];
                sl = ((ch + 1) * 64 + lane < count) ? (int)sv : 0;
                rkv = rk[rowbase + sl];
#pragma unroll
                for (int i = 0; i < 16; ++i) { const int srow = __shfl(sl, 4 * i + G); gr[i] = *(const u32x4*)(latb + (size_t)srow * PROJ_LD); }
            } else if (qi + NGW < TOK) {
                const unsigned short* sp = SEL + (size_t)(qi + NGW) * 256 + lane; selnext = (u32x4){sp[0], sp[64], sp[128], sp[192]};
            }
            LDS_WAIT();
            float pl[4][4];
#pragma unroll
            for (int kt4 = 0; kt4 < 4; ++kt4) {
                const unsigned arow = 32 * (kt4 >> 1) + 8 * (c16 >> 2) + 4 * (kt4 & 1) + (c16 & 3);
                f32x4 acc = (f32x4){0.f, 0.f, 0.f, 0.f};
#pragma unroll
                for (int kk = 0; kk < 4; ++kk) { const bf16x8 a = *(const LAS bf16x8*)(tile + off_b(arow, 4 * kk + G)); acc = __builtin_amdgcn_mfma_f32_16x16x32_bf16(a, qf[kk], acc, 0, 0, 0); }
                const int rho = 32 * (kt4 >> 1) + 8 * G + 4 * (kt4 & 1);
                const u32x4 s4 = *(const LAS u32x4*)(selS + rho); const f32x4 r4 = *(const LAS f32x4*)(rS + rho);
#pragma unroll
                for (int reg = 0; reg < 4; ++reg) { const float lg = acc[reg] * r4[reg] + biasS[(int)s4[reg] + c16];
                    pl[kt4][reg] = __builtin_amdgcn_exp2f(lg - mshift); lrun += pl[kt4][reg]; }
            }
            bf16x8 pf[2];
#pragma unroll
            for (int ks = 0; ks < 2; ++ks) { u32x4 w; w.x = pg8::cvt_pk_bf16(pl[2 * ks][0], pl[2 * ks][1]); w.y = pg8::cvt_pk_bf16(pl[2 * ks][2], pl[2 * ks][3]);
                w.z = pg8::cvt_pk_bf16(pl[2 * ks + 1][0], pl[2 * ks + 1][1]); w.w = pg8::cvt_pk_bf16(pl[2 * ks + 1][2], pl[2 * ks + 1][3]); pf[ks] = __builtin_bit_cast(bf16x8, w); }
            const unsigned q4 = (lane & 15) >> 2, p4 = lane & 3;
#pragma unroll
            for (int dt = 0; dt < 8; ++dt) {
#pragma unroll
                for (int ks = 0; ks < 2; ++ks) {
                    const s16x4 lo = __builtin_bit_cast(s16x4, __builtin_amdgcn_ds_read_tr16_b64_v4i16((LAS s16x4*)(tile + off_b(32 * ks + 8 * G + q4, 2 * dt + (p4 >> 1)) + 8 * (p4 & 1))));
                    const s16x4 hh = __builtin_bit_cast(s16x4, __builtin_amdgcn_ds_read_tr16_b64_v4i16((LAS s16x4*)(tile + off_b(32 * ks + 8 * G + 4 + q4, 2 * dt + (p4 >> 1)) + 8 * (p4 & 1))));
                    const bf16x8 vf = (bf16x8){lo[0], lo[1], lo[2], lo[3], hh[0], hh[1], hh[2], hh[3]};
                    o[dt] = __builtin_amdgcn_mfma_f32_16x16x32_bf16(vf, pf[ks], o[dt], 0, 0, 0);
                }
            }
            LDS_WAIT();
        }
        selreg = selnext;
        lrun += __shfl_xor(lrun, 16); lrun += __shfl_xor(lrun, 32);
        const float inv = 1.f / lrun;
        bf16_t* op = OL + (rowbase + t) * 2048 + c16 * 128 + 4 * G;
#pragma unroll
        for (int dt = 0; dt < 8; ++dt) { u32x2 w; w.x = pg8::cvt_pk_bf16(o[dt][0] * inv, o[dt][1] * inv); w.y = pg8::cvt_pk_bf16(o[dt][2] * inv, o[dt][3] * inv); *(u32x2*)(op + 16 * dt) = w; }
    }
}

template <class Epi> __device__ __forceinline__ void run_gemm(LAS unsigned char* lds, const bf16_t* A, const bf16_t* Bt, int N, int K, const Epi& E) {
    pg8::Gemm g{A, Bt, TOK, N, K}; pg8::StaticOrder S; S.init(TOK, N, (int)gridDim.x, (int)blockIdx.x);
    pg8::gemm_phase<Epi, pg8::StaticOrder, true, true>(lds, g, S, E);
}

#define RLX_AGENT __ATOMIC_RELAXED, __HIP_MEMORY_SCOPE_AGENT
#define XB_TMO      128
#define XB_XCNT(j)  (256  + 64 * (j))
#define XB_XSUB(j)  (1280 + 64 * (j))
#define XB_XGEN(j)  (2304 + 64 * (j))
#define XB_TOP      3328
#define XB_TOPGEN   3392
#define XCD_BAR_WORDS 3456
#define XB_SPIN_CAP (1u << 18)

__device__ __forceinline__ unsigned xb_ld(unsigned* p)              { return __hip_atomic_load(p, __ATOMIC_RELAXED, __HIP_MEMORY_SCOPE_AGENT); }
__device__ __forceinline__ unsigned xb_add(unsigned* p, unsigned v) { return __hip_atomic_fetch_add(p, v, __ATOMIC_RELAXED, __HIP_MEMORY_SCOPE_AGENT); }
__device__ __forceinline__ unsigned xb_xcc_id() { return (unsigned)__builtin_amdgcn_s_getreg((3 << 11) | 20) & 0xFu; }
#define XB_SPIN(cond, bar) do { unsigned _sp = 0; while (cond) { __builtin_amdgcn_s_sleep(1); \
    if ((++_sp & 255u) == 0u) { if (xb_ld(&(bar)[XB_TMO])) break; if (_sp > XB_SPIN_CAP) { atomicAdd(&(bar)[XB_TMO], 1u); break; } } } } while (0)

struct XcdBarrier {
    unsigned* bar; unsigned x;
    volatile LAS unsigned* st;
};

__device__ __forceinline__ XcdBarrier xcd_barrier_post(unsigned* bar, volatile LAS unsigned* st) {
    XcdBarrier b; b.bar = bar; b.x = xb_xcc_id(); b.st = st;
    if (threadIdx.x == 0) (void)xb_add(&bar[XB_XCNT(b.x)], 1u);
    return b;
}
__device__ __forceinline__ void xcd_barrier_complete(unsigned* bar, unsigned x, unsigned& nloc, unsigned& nx) {
    const unsigned G = gridDim.x * gridDim.y * gridDim.z;
    unsigned sum, cnt, mine, sp = 0u;
    for (;;) {
        sum = 0u; cnt = 0u; mine = 0u;
#pragma unroll
        for (unsigned j = 0; j < 16; ++j) { const unsigned c = xb_ld(&bar[XB_XCNT(j)]); sum += c; cnt += (c > 0u) ? 1u : 0u; mine = (j == x) ? c : mine; }
        if (sum == G) break;
        __builtin_amdgcn_s_sleep(1);
        if ((++sp & 255u) == 0u) { if (xb_ld(&bar[XB_TMO])) break; if (sp > XB_SPIN_CAP) { atomicAdd(&bar[XB_TMO], 1u); break; } }
    }
    nloc = mine > 0u ? mine : 1u; nx = cnt > 0u ? cnt : 1u;
}

__device__ __forceinline__ void xcd_barrier(const XcdBarrier& b) {
    asm volatile("s_waitcnt vmcnt(0)" ::: "memory");
    __syncthreads();
    if (threadIdx.x == 0) {
        unsigned* bar = b.bar;
        __builtin_amdgcn_s_waitcnt(0);
        unsigned nloc = b.st[0], nx = b.st[1];
        if (nloc == 0u) { xcd_barrier_complete(bar, b.x, nloc, nx); b.st[0] = nloc; b.st[1] = nx; }
        const unsigned old = xb_add(&bar[XB_XSUB(b.x)], 1u);
        const unsigned gen = old / nloc;
        if (old + 1u == (gen + 1u) * nloc) {
            __builtin_amdgcn_fence(__ATOMIC_RELEASE, "agent");
            asm volatile("s_waitcnt vmcnt(0)" ::: "memory");
            const unsigned og = xb_add(&bar[XB_TOP], 1u);
            const unsigned tg = og / nx;
            if (og + 1u == (tg + 1u) * nx) xb_add(&bar[XB_TOPGEN], 1u);
            else XB_SPIN(xb_ld(&bar[XB_TOPGEN]) == tg, bar);
            __builtin_amdgcn_fence(__ATOMIC_ACQUIRE, "agent");
            xb_add(&bar[XB_XGEN(b.x)], 1u);
            asm volatile("s_waitcnt vmcnt(0)" ::: "memory");
        } else {
            XB_SPIN(xb_ld(&bar[XB_XGEN(b.x)]) == gen, bar);
            __builtin_amdgcn_fence(__ATOMIC_ACQUIRE, "agent");
            asm volatile("s_waitcnt vmcnt(0)" ::: "memory");
        }
    }
    __syncthreads();
}

typedef const Params __attribute__((address_space(4)))* KArgs;
#define PHASE_BEGIN { KArgs q = (KArgs)__builtin_amdgcn_kernarg_segment_ptr(); asm volatile("" : "+s"(q)); unsigned char* ws = q->ws; (void)ws;
#define PHASE_END } GRID_SYNC();
#define GRID_SYNC() xcd_barrier(bar)
#define WSP(T, off) ((T*)(ws + (off)))
__global__ void __launch_bounds__(NTHR, 2) mega_fwd(Params p_unused) {
    extern __shared__ __attribute__((aligned(16))) unsigned char lds_raw[];
    LAS unsigned char* lds = (LAS unsigned char*)lds_raw;
    cg::grid_group grid = cg::this_grid();
    volatile LAS unsigned* st = (volatile LAS unsigned*)(lds + LDS_PHASE_BYTES);
    if (threadIdx.x < 4) st[threadIdx.x] = 0u;
    __syncthreads();
    XcdBarrier bar;
    { KArgs q = (KArgs)__builtin_amdgcn_kernarg_segment_ptr(); bar = xcd_barrier_post((unsigned*)(q->ws + WS_BAR), st); }

    PHASE_BEGIN { Params p; for (int i = 0; i < 18; ++i) p.in[i] = q->in[i]; p.out = q->out; p.ws = q->ws; p0_prologue(p, lds); }
        if (q->ws == nullptr) grid.sync();
    PHASE_END
    PHASE_BEGIN { Params p; for (int i = 0; i < 18; ++i) p.in[i] = q->in[i]; p.out = q->out; p.ws = q->ws; p0_weights(p, lds); }
        norm_phase(q->in[0], q->in[4], WSP(float, WS_MOD), 0, 1024, WSP(bf16_t, WS_H)); PHASE_END
    PHASE_BEGIN EpiBf16 E{WSP(bf16_t, WS_A), DM, DM, (size_t)TOK * DM, 0.125f * LOG2E}; run_gemm(lds, WSP(bf16_t, WS_H), WSP(bf16_t, WS_WQKV), 3 * DM, DM, E); PHASE_END
    PHASE_BEGIN bf16_t* RA = WSP(bf16_t, WS_A); sb_attn_phase(RA, RA + (size_t)TOK * DM, RA + (size_t)2 * TOK * DM, WSP(bf16_t, WS_B), lds); PHASE_END
    PHASE_BEGIN EpiResid E{q->in[0], q->out, WSP(float, WS_MOD) + 2048}; run_gemm(lds, WSP(bf16_t, WS_B), WSP(bf16_t, WS_WSBO), DM, DM, E); PHASE_END
    PHASE_BEGIN norm_phase(q->out, q->in[5], WSP(float, WS_MOD), 3072, 4096, WSP(bf16_t, WS_H)); PHASE_END
    PHASE_BEGIN EpiConvGate E{WSP(bf16_t, WS_A), WSP(float, WS_HF), WSP(float, WS_HL), q->in[15], q->in[16]}; run_gemm(lds, WSP(bf16_t, WS_H), WSP(bf16_t, WS_WUP0), FFN2, DM, E); PHASE_END
    PHASE_BEGIN fixup_phase(WSP(float, WS_HF), WSP(float, WS_HL), q->in[15], q->in[16], WSP(bf16_t, WS_A)); PHASE_END
    PHASE_BEGIN EpiResid E{q->out, q->out, WSP(float, WS_MOD) + 5120}; run_gemm(lds, WSP(bf16_t, WS_A), WSP(bf16_t, WS_WDN0), DM, FFN, E); PHASE_END
    PHASE_BEGIN norm_phase(q->out, q->in[4] + DM, WSP(float, WS_MOD) + 8 * 6144, 0, 1024, WSP(bf16_t, WS_H)); PHASE_END
    PHASE_BEGIN EpiBf16 E{WSP(bf16_t, WS_A), PROJ_LD, 0, 0, 1.f}; run_gemm(lds, WSP(bf16_t, WS_H), WSP(bf16_t, WS_WDIN), PROJ_LD, DM, E); PHASE_END
    PHASE_BEGIN indexer_phase(WSP(bf16_t, WS_A), WSP(float, WS_RK), WSP(unsigned short, WS_SEL), lds); PHASE_END
    PHASE_BEGIN dsa_attn_phase(WSP(bf16_t, WS_A), WSP(float, WS_RK), WSP(unsigned short, WS_SEL), WSP(float, WS_BIASD), q->in[9], q->in[10], WSP(bf16_t, WS_B), lds); PHASE_END
    PHASE_BEGIN EpiResid E{q->out, q->out, WSP(float, WS_MOD) + 8 * 6144 + 2048}; run_gemm(lds, WSP(bf16_t, WS_B), WSP(bf16_t, WS_WDO), DM, 2 * DM, E); PHASE_END
    PHASE_BEGIN norm_phase(q->out, q->in[5] + DM, WSP(float, WS_MOD) + 8 * 6144, 3072, 4096, WSP(bf16_t, WS_H)); PHASE_END
    PHASE_BEGIN EpiConvGate E{WSP(bf16_t, WS_A), WSP(float, WS_HF), WSP(float, WS_HL), q->in[15] + 3 * FFN2, q->in[16] + FFN2}; run_gemm(lds, WSP(bf16_t, WS_H), WSP(bf16_t, WS_WUP1), FFN2, DM, E); PHASE_END
    PHASE_BEGIN fixup_phase(WSP(float, WS_HF), WSP(float, WS_HL), q->in[15] + 3 * FFN2, q->in[16] + FFN2, WSP(bf16_t, WS_A)); PHASE_END
    { KArgs q = (KArgs)__builtin_amdgcn_kernarg_segment_ptr(); asm volatile("" : "+s"(q)); unsigned char* ws = q->ws;
      EpiResid E{q->out, q->out, WSP(float, WS_MOD) + 8 * 6144 + 5120}; run_gemm(lds, WSP(bf16_t, WS_A), WSP(bf16_t, WS_WDN1), DM, FFN, E); }
}

extern "C" void kernel_launch(void* const* d_in, const int* in_sizes, int n_in, void* d_out, int out_size, void* d_ws, size_t ws_size, hipStream_t stream) {
    static int grid = 0;
    if (grid == 0) {
        if (n_in != 18 || out_size != TOK * DM || ws_size < WS_END) { fprintf(stderr, "kernel_launch: unexpected shapes (n_in %d, out %d, ws %zu)\n", n_in, out_size, ws_size); grid = -1; return; }
        int dev = 0, cus = 0, per_cu = 0;
        hipGetDevice(&dev);
        hipDeviceGetAttribute(&cus, hipDeviceAttributeMultiprocessorCount, dev);
        if (hipFuncSetAttribute((const void*)mega_fwd, hipFuncAttributeMaxDynamicSharedMemorySize, LDS_BYTES) != hipSuccess) { fprintf(stderr, "kernel_launch: hipFuncSetAttribute failed\n"); grid = -1; return; }
        if (hipOccupancyMaxActiveBlocksPerMultiprocessor(&per_cu, (const void*)mega_fwd, NTHR, LDS_BYTES) != hipSuccess || per_cu < 1) { fprintf(stderr, "kernel_launch: occupancy query says %d\n", per_cu); per_cu = 1; }
        (void)hipGetLastError();
        grid = cus * 1;
        fprintf(stderr, "kernel_launch: grid %d (cus %d, per_cu %d)\n", grid, cus, per_cu);
    }
    if (grid < 0) return;
    Params p{};
    for (int i = 0; i < 18; ++i) p.in[i] = (const float*)d_in[i];
    p.out = (float*)d_out; p.ws = (unsigned char*)d_ws;
    void* args[] = {&p};
    if (hipMemsetAsync((char*)d_ws + WS_BAR, 0, XCD_BAR_WORDS * 4, stream) != hipSuccess) { fprintf(stderr, "kernel_launch: memset failed\n"); return; }
    hipError_t e = hipLaunchCooperativeKernel((const void*)mega_fwd, dim3(grid), dim3(NTHR), args, LDS_BYTES, stream);
    if (e != hipSuccess) fprintf(stderr, "cooperative launch failed: %s (grid %d)\n", hipGetErrorString(e), grid);
}
```

```cpp
#include <hip/hip_runtime.h>
#include <hip/hip_cooperative_groups.h>
#include <cstdio>
#include <cstdint>
namespace cg = cooperative_groups;

__device__ __forceinline__ int fresh_tid() { int t = threadIdx.x; asm volatile("" : "+v"(t)); return t; }
namespace pg8 {
#define PG8_LAS __attribute__((address_space(3)))
typedef unsigned short bf16_t;
typedef short bf16x8 __attribute__((ext_vector_type(8)));
typedef float f32x4 __attribute__((ext_vector_type(4)));
typedef unsigned u32x4 __attribute__((ext_vector_type(4)));
constexpr int BM = 256, BK = 64, HALF = 128, HTB = HALF * BK * 2  , STAGE_BYTES = 8 * HTB, NXCD = 8, WGM = 8;

__host__ __device__ __forceinline__ int lds_byte(int r, int c) { const int st = (r >> 4) * 2 + (c >> 5), rr = r & 15, cc = c & 31, ob = rr * 64 + cc * 2; return st * 1024 + (ob ^ (((ob >> 9) & 1) << 5)); }
__host__ __device__ __forceinline__ void stage_rc(int b, int& R, int& C) { const int st = b / 1024, sb = b % 1024, swz = sb ^ (((sb >> 9) & 1) << 5); R = (st >> 1) * 16 + swz / 64; C = (st & 1) * 32 + (swz % 64) / 2; }
__host__ __device__ __forceinline__ int perm32(int rho) { const int n = rho >> 4, i = rho & 15; return 8 * (i >> 2) + 4 * n + (i & 3); }

struct Unit { int pm, pn; };
struct Gemm { const bf16_t* A; const bf16_t* Bt; int M, N, K; };

struct StaticOrder {
    int nM, nN, nwg, G, c;
    __host__ __device__ void init(int M, int N, int G_, int c_) { nM = M / BM; nN = N / BM; nwg = nM * nN; G = G_; c = c_; }
    __host__ __device__ bool next(int i, Unit& u) const {
        const long L = (long)i * G + c; if (L >= nwg) return false;
        int wgid = (int)L; { const int q = nwg / NXCD, r = nwg % NXCD, xcd = wgid % NXCD, off = wgid / NXCD; wgid = (xcd < r ? xcd * (q + 1) : r * (q + 1) + (xcd - r) * q) + off; }
        const int nig = WGM * nN, gid = wgid / nig, fm = gid * WGM, gsz = (nM - fm) < WGM ? (nM - fm) : WGM;
        u.pm = fm + ((wgid % nig) % gsz); u.pn = (wgid % nig) / gsz; return true;
    }
    __device__ __forceinline__ void a_ready(const Unit&) const {}
    __device__ __forceinline__ void done(const Unit&) const {}
};

__device__ __forceinline__ unsigned cvt_pk_bf16(float lo, float hi) { unsigned r; asm volatile("v_cvt_pk_bf16_f32 %0, %1, %2" : "=v"(r) : "v"(lo), "v"(hi)); return r; }
template <class Epi, class Sched, bool ALIGN_EPI = false, bool SP2 = false>
__device__ __forceinline__ void gemm_phase(PG8_LAS unsigned char* lds, const Gemm g, const Sched& S, const Epi& E) {
    const int tid = fresh_tid(), wid = __builtin_amdgcn_readfirstlane(tid >> 6), lane = tid & 63, wr = wid >> 2, wc = wid & 3, fr = lane & 15, fq = lane >> 4;
    const int K = g.K, nt = K / BK;
    unsigned voffA[2], voffB[2];
#pragma unroll
    for (int i = 0; i < 2; ++i) { int R, C; stage_rc(tid * 16 + i * 8192, R, C); const int Rb = Epi::PERM ? ((R & ~31) + perm32(R & 31)) : R;
        voffA[i] = (unsigned)(R * K + C) * 2u; voffB[i] = (unsigned)(Rb * K + C) * 2u; }
    const size_t kstep = (size_t)(BK * 2);
    const size_t hstep = (size_t)HALF * K * 2;
    const size_t tstep = 2 * hstep;
    const unsigned ldsw = (unsigned)wid * 1024u;
    const int aoff = lds_byte(wr * 64 + fr, fq * 8), boff = lds_byte(wc * 32 + fr, fq * 8);
#define PG8_SA(b, h) (((b) * 2 + (h)) * HTB)
#define PG8_SB(b, h) ((4 + (b) * 2 + (h)) * HTB)
#define PG8_STAGE(bufoff, gbase, voff) do { _Pragma("unroll") for (int _i = 0; _i < 2; ++_i) \
        __builtin_amdgcn_global_load_lds((const unsigned*)((const char*)(gbase) + (voff)[_i]), (PG8_LAS unsigned*)(lds + (bufoff) + ldsw + _i * 8192), 16, 0, 0); } while (0)
#define PG8_LDA(dst, b, h) do { _Pragma("unroll") for (int m = 0; m < 4; ++m) _Pragma("unroll") for (int k = 0; k < 2; ++k) dst[m][k] = *(const PG8_LAS bf16x8*)(lds + PG8_SA(b, h) + aoff + m * 2048 + k * 1024); } while (0)
#define PG8_LDB(dst, b, h) do { _Pragma("unroll") for (int n = 0; n < 2; ++n) _Pragma("unroll") for (int k = 0; k < 2; ++k) dst[n][k] = *(const PG8_LAS bf16x8*)(lds + PG8_SB(b, h) + boff + n * 2048 + k * 1024); } while (0)
#define PG8_MMA(ai, bj, At, Bt) do { __builtin_amdgcn_s_setprio(1); _Pragma("unroll") for (int m = 0; m < 4; ++m) _Pragma("unroll") for (int n = 0; n < 2; ++n) _Pragma("unroll") for (int k = 0; k < 2; ++k) \
        acc[ai][bj][m][n] = __builtin_amdgcn_mfma_f32_16x16x32_bf16(Bt[n][k], At[m][k], acc[ai][bj][m][n], 0, 0, 0); __builtin_amdgcn_s_setprio(0); } while (0)
#define PG8_WAIT_V(n) asm volatile("s_waitcnt vmcnt(" #n ")" ::: "memory")
#define PG8_WAIT_L(n) asm volatile("s_waitcnt lgkmcnt(" #n ")" ::: "memory")
#define PG8_BAR __builtin_amdgcn_s_barrier()
#define PG8_SCHED __builtin_amdgcn_sched_barrier(0)
    Unit cur, nxt; int ui = 0;
    if (!S.next(0, cur)) return;
    f32x4 acc[2][2][4][2];
#pragma unroll
    for (int a = 0; a < 2; ++a)
#pragma unroll
        for (int b = 0; b < 2; ++b)
#pragma unroll
            for (int m = 0; m < 4; ++m)
#pragma unroll
                for (int n = 0; n < 2; ++n) acc[a][b][m][n] = (f32x4){0.f, 0.f, 0.f, 0.f};
    bf16x8 At[4][2], B0[2][2], B1[2][2];
    const char* cA = (const char*)g.A + (size_t)cur.pm * tstep; const char* cB = (const char*)g.Bt + (size_t)cur.pn * tstep;
    S.a_ready(cur);
    if constexpr (SP2) {
        PG8_STAGE(PG8_SB(0, 0), cB, voffB); PG8_STAGE(PG8_SB(0, 1), cB + hstep, voffB); PG8_STAGE(PG8_SA(0, 0), cA, voffA); PG8_STAGE(PG8_SA(0, 1), cA + hstep, voffA);
        if (wr == 1) PG8_BAR;
        PG8_WAIT_V(2); PG8_BAR;
        PG8_STAGE(PG8_SB(1, 0), cB + kstep, voffB); PG8_STAGE(PG8_SA(1, 0), cA + kstep, voffA); PG8_STAGE(PG8_SB(1, 1), cB + hstep + kstep, voffB);
        PG8_WAIT_V(6); PG8_BAR;
    } else {
        PG8_STAGE(PG8_SB(0, 0), cB, voffB); PG8_STAGE(PG8_SA(0, 0), cA, voffA); PG8_STAGE(PG8_SB(0, 1), cB + hstep, voffB); PG8_STAGE(PG8_SA(0, 1), cA + hstep, voffA);
        if (wr == 1) PG8_BAR;
        PG8_WAIT_V(4); PG8_BAR;
        PG8_STAGE(PG8_SB(1, 0), cB + kstep, voffB); PG8_STAGE(PG8_SA(1, 0), cA + kstep, voffA); PG8_STAGE(PG8_SB(1, 1), cB + hstep + kstep, voffB);
        PG8_WAIT_V(6); PG8_BAR;
    }
    for (;;) {
        const bool has_next = S.next(ui + 1, nxt);
        const char* nA = has_next ? (const char*)g.A + (size_t)nxt.pm * tstep : cA; const char* nB = has_next ? (const char*)g.Bt + (size_t)nxt.pn * tstep : cB;
        for (int t = 0; t < nt; t += 2) {
            const bool last = (t == nt - 2);
            const char* a1 = cA + (size_t)(t + 1) * kstep;
            const char* a2 = last ? nA : cA + (size_t)(t + 2) * kstep; const char* b2 = last ? nB : cB + (size_t)(t + 2) * kstep;
            const char* a3 = a2 + kstep; const char* b3 = b2 + kstep;
            if (last && has_next) S.a_ready(nxt);
            if constexpr (SP2) {
            PG8_LDB(B0, 0, 0); PG8_LDB(B1, 0, 1); PG8_SCHED; PG8_LDA(At, 0, 0); PG8_STAGE(PG8_SA(1, 1), a1 + hstep, voffA);
            PG8_WAIT_V(8); PG8_WAIT_L(0); PG8_BAR; PG8_MMA(0, 0, At, B0); PG8_MMA(0, 1, At, B1); PG8_BAR; PG8_SCHED;
            PG8_LDA(At, 0, 1); PG8_STAGE(PG8_SB(0, 0), b2, voffB); PG8_STAGE(PG8_SB(0, 1), b2 + hstep, voffB); PG8_STAGE(PG8_SA(0, 0), a2, voffA);
            PG8_WAIT_V(8); PG8_WAIT_L(0); PG8_BAR; PG8_MMA(1, 0, At, B0); PG8_MMA(1, 1, At, B1); PG8_BAR; PG8_SCHED;
            PG8_LDB(B0, 1, 0); PG8_LDB(B1, 1, 1); PG8_SCHED; PG8_LDA(At, 1, 0); PG8_STAGE(PG8_SA(0, 1), a2 + hstep, voffA);
            PG8_WAIT_V(8); PG8_WAIT_L(0); PG8_BAR; PG8_MMA(0, 0, At, B0); PG8_MMA(0, 1, At, B1); PG8_BAR; PG8_SCHED;
            PG8_LDA(At, 1, 1); PG8_STAGE(PG8_SB(1, 0), b3, voffB); PG8_STAGE(PG8_SB(1, 1), b3 + hstep, voffB); PG8_STAGE(PG8_SA(1, 0), a3, voffA);
            PG8_WAIT_V(8); PG8_WAIT_L(0); PG8_BAR; PG8_MMA(1, 0, At, B0); PG8_MMA(1, 1, At, B1); PG8_BAR; PG8_SCHED;
            } else {
            PG8_LDB(B0, 0, 0); PG8_SCHED; PG8_LDA(At, 0, 0); PG8_STAGE(PG8_SA(1, 1), a1 + hstep, voffA);
            PG8_WAIT_L(8); PG8_BAR; PG8_WAIT_L(0); PG8_MMA(0, 0, At, B0); PG8_BAR; PG8_SCHED;
            PG8_LDB(B1, 0, 1); PG8_STAGE(PG8_SB(0, 0), b2, voffB);
            PG8_BAR; PG8_WAIT_L(0); PG8_MMA(0, 1, At, B1); PG8_BAR;
            PG8_LDA(At, 0, 1); PG8_STAGE(PG8_SA(0, 0), a2, voffA);
            PG8_BAR; PG8_WAIT_L(0); PG8_MMA(1, 0, At, B0); PG8_BAR; PG8_SCHED;
            PG8_STAGE(PG8_SB(0, 1), b2 + hstep, voffB);
            PG8_WAIT_V(6); PG8_BAR; PG8_MMA(1, 1, At, B1); PG8_BAR;
            PG8_LDB(B0, 1, 0); PG8_SCHED; PG8_LDA(At, 1, 0); PG8_STAGE(PG8_SA(0, 1), a2 + hstep, voffA);
            PG8_WAIT_L(8); PG8_BAR; PG8_WAIT_L(0); PG8_MMA(0, 0, At, B0); PG8_BAR; PG8_SCHED;
            PG8_LDB(B1, 1, 1); PG8_STAGE(PG8_SB(1, 0), b3, voffB);
            PG8_BAR; PG8_WAIT_L(0); PG8_MMA(0, 1, At, B1); PG8_BAR;
            PG8_LDA(At, 1, 1); PG8_STAGE(PG8_SA(1, 0), a3, voffA);
            PG8_BAR; PG8_WAIT_L(0); PG8_MMA(1, 0, At, B0); PG8_BAR; PG8_SCHED;
            PG8_STAGE(PG8_SB(1, 1), b3 + hstep, voffB);
            PG8_WAIT_V(6); PG8_BAR; PG8_MMA(1, 1, At, B1); PG8_BAR;
            }
        }
        if constexpr (ALIGN_EPI) { if (wr == 0) PG8_BAR; }
        if constexpr (!Epi::AFTER_DRAIN) { E(acc, cur, wr, wc, fr, fq); S.done(cur); }
        if (!has_next) break;
#pragma unroll
        for (int a = 0; a < 2; ++a)
#pragma unroll
            for (int b = 0; b < 2; ++b)
#pragma unroll
                for (int m = 0; m < 4; ++m)
#pragma unroll
                    for (int n = 0; n < 2; ++n) acc[a][b][m][n] = (f32x4){0.f, 0.f, 0.f, 0.f};
        cur = nxt; cA = nA; cB = nB; ++ui;
        if constexpr (ALIGN_EPI) { if (wr == 1) PG8_BAR; }
    }
    PG8_WAIT_V(0);
    if constexpr (!ALIGN_EPI) { if (wr == 0) PG8_BAR; }
    PG8_BAR;
    if constexpr (Epi::AFTER_DRAIN) { E.fused(acc, cur, wr, wc, fr, fq, lds, wid, lane); S.done(cur); }
#undef PG8_SA
#undef PG8_SB
#undef PG8_STAGE
#undef PG8_LDA
#undef PG8_LDB
#undef PG8_MMA
#undef PG8_WAIT_V
#undef PG8_WAIT_L
#undef PG8_BAR
#undef PG8_SCHED
}
}

#define LAS __attribute__((address_space(3)))
typedef unsigned short bf16_t;
typedef short bf16x8 __attribute__((ext_vector_type(8)));
typedef short s16x4 __attribute__((ext_vector_type(4)));
typedef float f32x4 __attribute__((ext_vector_type(4)));
typedef float f32x16 __attribute__((ext_vector_type(16)));
typedef unsigned u32x4 __attribute__((ext_vector_type(4)));
typedef unsigned u32x2 __attribute__((ext_vector_type(2)));

constexpr int DM = 1024, NBATCH = 8, SEQ = 4096, TOK = NBATCH * SEQ, FFN = 2816, FFN2 = 5632;
constexpr int DSA_N = 2760, PROJ_LD = 2816;
constexpr int PJ_LAT = 2048, PJ_QI = 2176, PJ_KI = 2688, PJ_WI = 2752;
constexpr float RMS_EPS = 1e-6f, LOG2E = 1.4426950408889634f;
constexpr int NTHR = 512, NWAVE = 8;
constexpr int LDS_PHASE_BYTES = 156160, LDS_BYTES = LDS_PHASE_BYTES + 64;

constexpr size_t MiB = 1u << 20;
constexpr size_t WS_MOD = 0;
constexpr size_t WS_BIASD = 512 * 1024;
constexpr size_t WS_RK = 1 * MiB;
constexpr size_t WS_BAR = 1536 * 1024;
constexpr size_t WS_WQKV = 2 * MiB;
constexpr size_t WS_WSBO = 8 * MiB;
constexpr size_t WS_WDIN = 10 * MiB;
constexpr size_t WS_WDO = 16 * MiB;
constexpr size_t WS_WUP0 = 20 * MiB, WS_WUP1 = 31 * MiB;
constexpr size_t WS_WDN0 = 42 * MiB, WS_WDN1 = 48 * MiB;
constexpr size_t WS_HF = 54 * MiB, WS_HL = 76 * MiB;
constexpr size_t WS_H = 100 * MiB;
constexpr size_t WS_A = 164 * MiB;
constexpr size_t WS_B = 356 * MiB;
constexpr size_t WS_SEL = 484 * MiB;
constexpr size_t WS_END = 500 * MiB;

struct Params { const float* in[18]; float* out; unsigned char* ws; };

__device__ __forceinline__ unsigned f2bf(float f) { unsigned u = __builtin_bit_cast(unsigned, f); return (u + 0x7fffu + ((u >> 16) & 1u)) >> 16; }
__device__ __forceinline__ unsigned pk2(float lo, float hi) { return f2bf(lo) | (f2bf(hi) << 16); }
__device__ __forceinline__ float bflo(unsigned w) { return __builtin_bit_cast(float, w << 16); }
__device__ __forceinline__ float bfhi(unsigned w) { return __builtin_bit_cast(float, w & 0xffff0000u); }
__device__ __forceinline__ float wave_sum(float v) {
#pragma unroll
    for (int o = 1; o < 64; o <<= 1) v += __shfl_xor(v, o);
    return v;
}
#define LDS_WAIT() asm volatile("s_waitcnt lgkmcnt(0)" ::: "memory")

struct EpiBf16 {
    static constexpr bool PERM = true, AFTER_DRAIN = false;
    bf16_t* O; int ldc; int split_cols; size_t split_stride; float scale0;
    __device__ __forceinline__ void operator()(const f32x4 (&acc)[2][2][4][2], const pg8::Unit& u, int wr, int wc, int fr, int fq) const {
        const int row0 = u.pm * 256 + wr * 64 + fr; int colt = u.pn * 256; bf16_t* base = O;
        float sc = 1.f; if (split_cols) { const int t = colt / split_cols; base += (size_t)t * split_stride; colt -= t * split_cols; if (t == 0) sc = scale0; }
        const int col0 = colt + wc * 32 + 8 * fq;
#pragma unroll
        for (int ai = 0; ai < 2; ++ai)
#pragma unroll
            for (int m = 0; m < 4; ++m) { bf16_t* rowp = base + (size_t)(row0 + ai * 128 + m * 16) * ldc + col0;
#pragma unroll
                for (int bj = 0; bj < 2; ++bj) { const f32x4 v0 = acc[ai][bj][m][0] * sc, v1 = acc[ai][bj][m][1] * sc;
                    u32x4 w; w.x = pg8::cvt_pk_bf16(v0[0], v0[1]); w.y = pg8::cvt_pk_bf16(v0[2], v0[3]); w.z = pg8::cvt_pk_bf16(v1[0], v1[1]); w.w = pg8::cvt_pk_bf16(v1[2], v1[3]);
                    *(u32x4*)(rowp + bj * 128) = w; } }
    }
};
template <int CTRL> __device__ __forceinline__ float dpp_ror(float v) { return __builtin_bit_cast(float, __builtin_amdgcn_update_dpp(0, __builtin_bit_cast(int, v), CTRL, 0xf, 0xf, false)); }
struct EpiResid {
    static constexpr bool PERM = false, AFTER_DRAIN = false;
    const float* resid; float* out; const float* gate;
    __device__ __forceinline__ void operator()(const f32x4 (&acc)[2][2][4][2], const pg8::Unit& u, int wr, int wc, int fr, int fq) const {
        const float* g = gate + (size_t)(u.pm >> 4) * 6144;
        const int col0 = u.pn * 256 + wc * 32 + 4 * fq;
        f32x4 gv[2][2];
#pragma unroll
        for (int bj = 0; bj < 2; ++bj)
#pragma unroll
            for (int n = 0; n < 2; ++n) gv[bj][n] = *(const f32x4*)(g + col0 + bj * 128 + n * 16);
        const bool lo8 = fr < 8;
        const int rsel = fr & 7, csel = lo8 ? 0 : 16;
#pragma unroll
        for (int ai = 0; ai < 2; ++ai)
#pragma unroll
            for (int m = 0; m < 4; ++m) { const size_t off = (size_t)(u.pm * 256 + ai * 128 + wr * 64 + m * 16 + fr) * DM + col0;
                const size_t offs = (size_t)(u.pm * 256 + ai * 128 + wr * 64 + m * 16 + rsel) * DM + col0 + csel;
#pragma unroll
                for (int bj = 0; bj < 2; ++bj) {
                    const f32x4 a = *(const f32x4*)(resid + off + bj * 128) + gv[bj][0] * acc[ai][bj][m][0];
                    const f32x4 b = *(const f32x4*)(resid + off + bj * 128 + 16) + gv[bj][1] * acc[ai][bj][m][1];
                    f32x4 y;
#pragma unroll
                    for (int j = 0; j < 4; ++j) y[j] = dpp_ror<0x128>(lo8 ? b[j] : a[j]);
                    f32x4 s1, s2;
#pragma unroll
                    for (int j = 0; j < 4; ++j) { s1[j] = lo8 ? a[j] : y[j]; s2[j] = lo8 ? y[j] : b[j]; }
                    *(f32x4*)(out + offs + bj * 128) = s1;
                    *(f32x4*)(out + offs + (size_t)8 * DM + bj * 128) = s2;
                }
            }
    }
};
__device__ __forceinline__ float silu_f(float g) { return g * __builtin_amdgcn_rcpf(1.f + __builtin_amdgcn_exp2f(-g * LOG2E)); }
struct EpiConvGate {
    static constexpr bool PERM = true, AFTER_DRAIN = false;
    bf16_t* act; float* hf; float* hl; const float* cw; const float* cb;
    __device__ __forceinline__ void operator()(const f32x4 (&acc)[2][2][4][2], const pg8::Unit& u, int wr, int wc, int fr, int fq) const {
#pragma unroll
        for (int n = 0; n < 2; ++n) {
            const int f0 = u.pn * 128 + wc * 32 + 8 * fq + 4 * n;
            f32x4 w[2][3], bb[2];
#pragma unroll
            for (int bj = 0; bj < 2; ++bj) { const int col = bj * FFN + f0; bb[bj] = *(const f32x4*)(cb + col);
#pragma unroll
                for (int tp = 0; tp < 3; ++tp) w[bj][tp] = *(const f32x4*)(cw + tp * FFN2 + col); }
#pragma unroll
            for (int ai = 0; ai < 2; ++ai) {
                const int wb = (u.pm * 2 + ai) * 2 + wr;
                f32x4 p1[2], p2[2];
                p1[0] = p1[1] = p2[0] = p2[1] = (f32x4){0.f, 0.f, 0.f, 0.f};
#pragma unroll
                for (int m = 0; m < 4; ++m) {
                    f32x4 y[2];
#pragma unroll
                    for (int bj = 0; bj < 2; ++bj) {
                        const f32x4 cur = acc[ai][bj][m][n]; f32x4 r1, r2;
#pragma unroll
                        for (int j = 0; j < 4; ++j) { r1[j] = dpp_ror<0x121>(cur[j]); r2[j] = dpp_ror<0x122>(cur[j]); }
                        const f32x4 s1 = (fr >= 1) ? r1 : p1[bj], s2 = (fr >= 2) ? r2 : p2[bj];
                        y[bj] = bb[bj] + w[bj][0] * s2 + w[bj][1] * s1 + w[bj][2] * cur;
                        p1[bj] = r1; p2[bj] = r2;
                        if (m == 0 && fr < 2) *(f32x4*)(hf + (size_t)(wb * 2 + fr) * FFN2 + bj * FFN + f0) = cur;
                        if (m == 3 && fr >= 14) *(f32x4*)(hl + (size_t)(wb * 2 + fr - 14) * FFN2 + bj * FFN + f0) = cur;
                    }
                    u32x2 o; o.x = pg8::cvt_pk_bf16(silu_f(y[0][0]) * y[1][0], silu_f(y[0][1]) * y[1][1]); o.y = pg8::cvt_pk_bf16(silu_f(y[0][2]) * y[1][2], silu_f(y[0][3]) * y[1][3]);
                    *(u32x2*)(act + (size_t)(wb * 64 + m * 16 + fr) * FFN + f0) = o;
                }
            }
        }
    }
};

__device__ __forceinline__ void transpose_item(const float* W, int K, int N, bf16_t* WT, int dst_row0, LAS float* scr, int k0, int n0, int lane) {
    const int c4 = (lane & 7) * 4, n = n0 + c4;
#pragma unroll
    for (int i = 0; i < 8; ++i) { const int kk = 8 * i + (lane >> 3);
        const f32x4 v = (n < N) ? *(const f32x4*)(W + (size_t)(k0 + kk) * N + n) : (f32x4){0.f, 0.f, 0.f, 0.f};
        scr[kk * 33 + c4] = v[0]; scr[kk * 33 + c4 + 1] = v[1]; scr[kk * 33 + c4 + 2] = v[2]; scr[kk * 33 + c4 + 3] = v[3]; }
    LDS_WAIT();
    const int c = lane & 7;
#pragma unroll
    for (int j = 0; j < 4; ++j) { const int nn = (lane >> 3) + 8 * j; const LAS float* s = scr + (8 * c) * 33 + nn;
        u32x4 o; o.x = pk2(s[0 * 33], s[1 * 33]); o.y = pk2(s[2 * 33], s[3 * 33]); o.z = pk2(s[4 * 33], s[5 * 33]); o.w = pk2(s[6 * 33], s[7 * 33]);
        *(u32x4*)(WT + (size_t)(dst_row0 + nn) * K + k0 + 8 * c) = o; }
    LDS_WAIT();
}
__device__ __forceinline__ int t5_bucket(int n) {
    if (n < 16) return n;
    return 16 + (n >= 19) + (n >= 21) + (n >= 24) + (n >= 27) + (n >= 31) + (n >= 35) + (n >= 40) + (n >= 46) + (n >= 52) + (n >= 59) + (n >= 67) + (n >= 77) + (n >= 87) + (n >= 99) + (n >= 113);
}
__device__ __forceinline__ void p0_prologue(const Params& p, LAS unsigned char* lds) {
    const int tid = fresh_tid(), lane = tid & 63, wave = tid >> 6, G = gridDim.x;
    const int gw = blockIdx.x * NWAVE + wave, NGW = G * NWAVE;
    unsigned char* ws = p.ws;
    {
        LAS float* condS = (LAS float*)lds;
        LAS float* red = (LAS float*)(lds + 32768);
        if ((int)blockIdx.x < 192) {
            for (int e = tid; e < NBATCH * DM; e += NTHR) { const float c = p.in[1][e]; condS[e] = c / (1.f + __expf(-c)); }
            __syncthreads();
        }
        for (int item = blockIdx.x; item < 192; item += G) {
            const int l = item / 96, col0 = (item % 96) * 64, col = tid & 63, kg = tid >> 6;
            const float* W = p.in[2] + (size_t)l * DM * 6144 + col0 + col;
            float a[8];
#pragma unroll
            for (int b = 0; b < 8; ++b) a[b] = 0.f;
#pragma unroll 8
            for (int k = kg * 128; k < kg * 128 + 128; ++k) { const float w = W[(size_t)k * 6144];
#pragma unroll
                for (int b = 0; b < 8; ++b) a[b] += condS[b * DM + k] * w; }
#pragma unroll
            for (int b = 0; b < 8; ++b) red[(kg * 8 + b) * 64 + col] = a[b];
            __syncthreads();
            { const int b = tid >> 6; float s = 0.f;
#pragma unroll
              for (int g = 0; g < 8; ++g) s += red[(g * 8 + b) * 64 + col];
              ((float*)(ws + WS_MOD))[(size_t)(l * 8 + b) * 6144 + col0 + col] = s + p.in[3][l * 6144 + col0 + col]; }
            __syncthreads();
        }
        __syncthreads();
    }
    { const int g = blockIdx.x * NTHR + tid; if (g < 2048) ((float*)(ws + WS_BIASD))[g] = p.in[13][t5_bucket(g >> 4) * 16 + (g & 15)] * LOG2E; }
}
__device__ __forceinline__ void p0_weights(const Params& p, LAS unsigned char* lds) {
    const int tid = fresh_tid(), lane = tid & 63, wave = tid >> 6, G = gridDim.x;
    const int gw = blockIdx.x * NWAVE + wave, NGW = G * NWAVE;
    unsigned char* ws = p.ws;
    {
        LAS float* scr = (LAS float*)(lds + wave * 16384);
        for (int it = gw; it < 11904; it += NGW) {
            const float* W; int K, N, nblk, mode = 0, r = it; bf16_t* WT;
            if (r < 1536) { W = p.in[6]; K = 1024; N = 3072; nblk = 96; WT = (bf16_t*)(ws + WS_WQKV); }
            else if ((r -= 1536) < 512) { W = p.in[7]; K = 1024; N = 1024; nblk = 32; WT = (bf16_t*)(ws + WS_WSBO); }
            else if ((r -= 512) < 1408) { W = p.in[8]; K = 1024; N = DSA_N; nblk = 88; WT = (bf16_t*)(ws + WS_WDIN); }
            else if ((r -= 1408) < 2816) { W = p.in[14]; K = 1024; N = FFN2; nblk = 176; WT = (bf16_t*)(ws + WS_WUP0); mode = 1; }
            else if ((r -= 2816) < 2816) { W = p.in[14] + (size_t)DM * FFN2; K = 1024; N = FFN2; nblk = 176; WT = (bf16_t*)(ws + WS_WUP1); mode = 1; }
            else if ((r -= 2816) < 1408) { W = p.in[17]; K = FFN; N = 1024; nblk = 32; WT = (bf16_t*)(ws + WS_WDN0); }
            else { r -= 1408; W = p.in[17] + (size_t)FFN * DM; K = FFN; N = 1024; nblk = 32; WT = (bf16_t*)(ws + WS_WDN1); }
            const int kb = r / nblk, nb = r % nblk, n0 = nb * 32;
            int dst = n0;
            if (mode == 1) { const int bj = n0 / FFN, f = n0 % FFN; dst = 256 * (f / 128) + 128 * bj + (f % 128); }
            transpose_item(W, K, N, WT, dst, scr, kb * 64, n0, lane);
        }
    }
    for (int it = gw; it < 4096; it += NGW) {
        const int n0 = (it >> 5) * 8, k = (it & 31) * 64 + lane, h = k >> 7;
        const float* uv = p.in[11] + (size_t)k * 64;
        const float* wo = p.in[12] + (size_t)(h * 64) * DM + n0;
        float a[8];
#pragma unroll
        for (int i = 0; i < 8; ++i) a[i] = 0.f;
#pragma unroll 4
        for (int v4 = 0; v4 < 16; ++v4) { const f32x4 x = *(const f32x4*)(uv + v4 * 4);
#pragma unroll
            for (int j = 0; j < 4; ++j) { const f32x4 w0 = *(const f32x4*)(wo + (size_t)(v4 * 4 + j) * DM), w1 = *(const f32x4*)(wo + (size_t)(v4 * 4 + j) * DM + 4);
                a[0] += x[j] * w0[0]; a[1] += x[j] * w0[1]; a[2] += x[j] * w0[2]; a[3] += x[j] * w0[3];
                a[4] += x[j] * w1[0]; a[5] += x[j] * w1[1]; a[6] += x[j] * w1[2]; a[7] += x[j] * w1[3]; } }
        bf16_t* WT = (bf16_t*)(ws + WS_WDO);
#pragma unroll
        for (int i = 0; i < 8; ++i) WT[(size_t)(n0 + i) * 2048 + k] = (bf16_t)f2bf(a[i]);
    }
}

__device__ __forceinline__ void norm_phase(const float* src, const float* gain, const float* mod_l, int sh_off, int sc_off, bf16_t* dst) {
    const int tid = fresh_tid(), lane = tid & 63, gw = blockIdx.x * NWAVE + (tid >> 6), NGW = gridDim.x * NWAVE;
    const int rpw = (TOK + NGW - 1) / NGW, r0 = gw * rpw, r1 = (r0 + rpw < TOK) ? r0 + rpw : TOK;
    f32x4 cs[4], sh[4], vn[4], vm[4]; int cur_b = -1;
#pragma unroll
    for (int j = 0; j < 4; ++j) { vn[j] = (f32x4){0.f, 0.f, 0.f, 0.f}; vm[j] = vn[j]; }
    if (r0 < r1) { const f32x4* x0 = (const f32x4*)(src + (size_t)r0 * DM) + lane;
#pragma unroll
        for (int j = 0; j < 4; ++j) vn[j] = x0[64 * j]; }
    if (r0 + 1 < r1) { const f32x4* x1 = (const f32x4*)(src + (size_t)(r0 + 1) * DM) + lane;
#pragma unroll
        for (int j = 0; j < 4; ++j) vm[j] = x1[64 * j]; }
    for (int row = r0; row < r1; ++row) {
        const int b = row >> 12;
        if (b != cur_b) { const float* mb = mod_l + (size_t)b * 6144;
#pragma unroll
            for (int j = 0; j < 4; ++j) { const int col = 4 * lane + 256 * j;
                cs[j] = *(const f32x4*)(gain + col) * (*(const f32x4*)(mb + sc_off + col) + 1.f); sh[j] = *(const f32x4*)(mb + sh_off + col); }
            cur_b = b; }
        f32x4 v[4]; float ss = 0.f;
#pragma unroll
        for (int j = 0; j < 4; ++j) { v[j] = vn[j]; vn[j] = vm[j]; }
        if (row + 2 < r1) { const f32x4* xn = (const f32x4*)(src + (size_t)(row + 2) * DM) + lane;
#pragma unroll
            for (int j = 0; j < 4; ++j) vm[j] = xn[64 * j]; }
#pragma unroll
        for (int j = 0; j < 4; ++j) ss += (v[j].x * v[j].x + v[j].y * v[j].y) + (v[j].z * v[j].z + v[j].w * v[j].w);
        const float r = rsqrtf(wave_sum(ss) * (1.f / DM) + RMS_EPS);
        u32x2* o8 = (u32x2*)(dst + (size_t)row * DM) + lane;
#pragma unroll
        for (int j = 0; j < 4; ++j) { const f32x4 y = v[j] * r * cs[j] + sh[j];
            u32x2 o; o.x = pk2(y[0], y[1]); o.y = pk2(y[2], y[3]); o8[64 * j] = o; }
    }
}

__device__ __forceinline__ void fixup_phase(const float* hf, const float* hl, const float* cw, const float* cb, bf16_t* act) {
    const int gt = blockIdx.x * NTHR + fresh_tid(), NT = gridDim.x * NTHR;
    const f32x4 zero4 = (f32x4){0.f, 0.f, 0.f, 0.f};
    for (int e = gt; e < 512 * 2 * (FFN / 4); e += NT) {
        const int f = 4 * (e % (FFN / 4)), j = (e / (FFN / 4)) & 1, wb = e / (2 * (FFN / 4));
        const bool first = (wb & 63) == 0;
        f32x4 y[2];
#pragma unroll
        for (int part = 0; part < 2; ++part) {
            const int col = part * FFN + f;
            const f32x4 u0 = *(const f32x4*)(hf + (size_t)(wb * 2 + j) * FFN2 + col);
            const f32x4 lm1 = first ? zero4 : *(const f32x4*)(hl + (size_t)((wb - 1) * 2 + 1) * FFN2 + col);
            const f32x4 lm2 = first ? zero4 : *(const f32x4*)(hl + (size_t)((wb - 1) * 2 + 0) * FFN2 + col);
            const f32x4 u1 = j ? *(const f32x4*)(hf + (size_t)(wb * 2) * FFN2 + col) : lm1;
            const f32x4 u2 = j ? lm1 : lm2;
            y[part] = *(const f32x4*)(cb + col) + *(const f32x4*)(cw + col) * u2 + *(const f32x4*)(cw + FFN2 + col) * u1 + *(const f32x4*)(cw + 2 * FFN2 + col) * u0;
        }
        u32x2 o; o.x = pk2(silu_f(y[0][0]) * y[1][0], silu_f(y[0][1]) * y[1][1]); o.y = pk2(silu_f(y[0][2]) * y[1][2], silu_f(y[0][3]) * y[1][3]);
        *(u32x2*)(act + (size_t)(wb * 64 + j) * FFN + f) = o;
    }
}

__device__ __forceinline__ int crow(int r, int hi) { return (r & 3) + 8 * (r >> 2) + 4 * hi; }
__device__ __forceinline__ float other_half(float x) { const unsigned u = __builtin_bit_cast(unsigned, x); auto rr = __builtin_amdgcn_permlane32_swap(u, u, false, false);
    return __builtin_bit_cast(float, (unsigned)(rr[0] ^ rr[1] ^ u)); }
__device__ __forceinline__ void sb_qk(const LAS unsigned char* tb, const bf16x8 (&qr)[4], f32x16& p0, f32x16& p1, unsigned krd) {
    constexpr int KPITCH = 144;
    p0 = f32x16{}; p1 = f32x16{};
#pragma unroll
    for (int d0 = 0; d0 < 4; ++d0) {
        const bf16x8 a0 = *(const LAS bf16x8*)(tb + krd + d0 * 32);
        const bf16x8 a1 = *(const LAS bf16x8*)(tb + krd + 32 * KPITCH + d0 * 32);
        p0 = __builtin_amdgcn_mfma_f32_32x32x16_bf16(a0, qr[d0], p0, 0, 0, 0);
        p1 = __builtin_amdgcn_mfma_f32_32x32x16_bf16(a1, qr[d0], p1, 0, 0, 0);
    }
}
template <bool BAND> __device__ __forceinline__ void sb_sigma(f32x16& p0, f32x16& p1, int j, int t, int hi) {
#pragma unroll
    for (int r = 0; r < 16; ++r) {
        p0[r] = __builtin_amdgcn_rcpf(1.f + __builtin_amdgcn_exp2f(-p0[r]));
        p1[r] = __builtin_amdgcn_rcpf(1.f + __builtin_amdgcn_exp2f(-p1[r]));
    }
    if (BAND) {
#pragma unroll
        for (int r = 0; r < 16; ++r) { const int kv = 64 * j + crow(r, hi); if (kv >= t) p0[r] = 0.f; if (kv + 32 >= t) p1[r] = 0.f; }
    }
}
__device__ __forceinline__ void sb_local(f32x16& p, float (&G)[4]) {
#pragma unroll
    for (int g = 0; g < 4; ++g) {
        const float k0 = 1.f - p[4 * g], k1 = 1.f - p[4 * g + 1], k2 = 1.f - p[4 * g + 2], k3 = 1.f - p[4 * g + 3];
        const float s2 = k3, s1 = k3 * k2, s0 = s1 * k1;
        p[4 * g + 2] *= s2; p[4 * g + 1] *= s1; p[4 * g] *= s0; G[g] = s0 * k0;
    }
}
__device__ __forceinline__ void sb_chain(const float (&G1)[4], const float (&G0)[4], float& acc, float (&mine1)[4], float (&mine0)[4], int r32, int hi) {
#pragma unroll
    for (int g = 3; g >= 0; --g) {
        const float gl = __shfl(G1[g], r32), gh = __shfl(G1[g], r32 + 32);
        const float m1 = acc; acc *= gh; const float m0 = acc; acc *= gl; mine1[g] = hi ? m1 : m0;
    }
#pragma unroll
    for (int g = 3; g >= 0; --g) {
        const float gl = __shfl(G0[g], r32), gh = __shfl(G0[g], r32 + 32);
        const float m1 = acc; acc *= gh; const float m0 = acc; acc *= gl; mine0[g] = hi ? m1 : m0;
    }
}
__device__ __forceinline__ void sb_pv(const LAS unsigned char* tb, const f32x16& p0, const f32x16& p1, const float (&mine0)[4], const float (&mine1)[4], f32x16 (&o)[2], unsigned vrd) {
#pragma unroll
    for (int X = 1; X >= 0; --X)
#pragma unroll
        for (int s = 0; s < 2; ++s) {
            u32x4 pw;
#define AV(i) (X == 0 ? p0[8 * s + (i)] * mine0[(8 * s + (i)) >> 2] : p1[8 * s + (i)] * mine1[(8 * s + (i)) >> 2])
            pw.x = pg8::cvt_pk_bf16(AV(0), AV(1)); pw.y = pg8::cvt_pk_bf16(AV(2), AV(3)); pw.z = pg8::cvt_pk_bf16(AV(4), AV(5)); pw.w = pg8::cvt_pk_bf16(AV(6), AV(7));
#undef AV
            const bf16x8 pf = __builtin_bit_cast(bf16x8, pw);
#pragma unroll
            for (int c = 0; c < 2; ++c) {
                const LAS unsigned char* vp = tb + vrd + ((8 * X + 4 * s) * 4 + 2 * c) * 128;
                const s16x4 lo = __builtin_bit_cast(s16x4, __builtin_amdgcn_ds_read_tr16_b64_v4i16((LAS s16x4*)(vp)));
                const s16x4 hh = __builtin_bit_cast(s16x4, __builtin_amdgcn_ds_read_tr16_b64_v4i16((LAS s16x4*)(vp + 2 * 4 * 128)));
                const bf16x8 vf = (bf16x8){lo[0], lo[1], lo[2], lo[3], hh[0], hh[1], hh[2], hh[3]};
                o[c] = __builtin_amdgcn_mfma_f32_32x32x16_bf16(vf, pf, o[c], 0, 0, 0);
            }
        }
}
__device__ __forceinline__ void sb_tile(const LAS unsigned char* tb, int j, const bf16x8 (&qr)[4], f32x16 (&o)[2], float& Rp, int t, int tq0, int r32, int hi, unsigned krd, unsigned vrd) {
    if (!(64 * j < tq0 + 31)) return;
    if (__all(Rp == 0.f)) return;
    f32x16 p0, p1; float G0[4], G1[4], mine0[4], mine1[4];
    sb_qk(tb, qr, p0, p1, krd);
    if (64 * j + 63 >= tq0) sb_sigma<true>(p0, p1, j, t, hi); else sb_sigma<false>(p0, p1, j, t, hi);
    sb_local(p0, G0); sb_local(p1, G1);
    sb_chain(G1, G0, Rp, mine1, mine0, r32, hi);
    sb_pv(tb, p0, p1, mine0, mine1, o, vrd);
}
__device__ __forceinline__ void sb_tile2(const LAS unsigned char* tbA, const LAS unsigned char* tbB, const bf16x8 (&qr)[4], f32x16 (&o)[2], float& Rp, int r32, int hi, unsigned krd, unsigned vrd) {
    if (__all(Rp == 0.f)) return;
    f32x16 a0, a1, b0, b1; float GA0[4], GA1[4], GB0[4], GB1[4], mA0[4], mA1[4], mB0[4], mB1[4];
    sb_qk(tbA, qr, a0, a1, krd);
    sb_qk(tbB, qr, b0, b1, krd);
    sb_sigma<false>(a0, a1, 0, 0, hi);
    sb_local(a0, GA0); sb_local(a1, GA1);
    sb_chain(GA1, GA0, Rp, mA1, mA0, r32, hi);
    sb_sigma<false>(b0, b1, 0, 0, hi);
    sb_pv(tbA, a0, a1, mA0, mA1, o, vrd);
    sb_local(b0, GB0); sb_local(b1, GB1);
    sb_chain(GB1, GB0, Rp, mB1, mB0, r32, hi);
    sb_pv(tbB, b0, b1, mB0, mB1, o, vrd);
}
__device__ __forceinline__ void sb_attn_phase(const bf16_t* Q, const bf16_t* K, const bf16_t* V, bf16_t* O, LAS unsigned char* lds) {
    constexpr int KPITCH = 144, KBYTES = 64 * KPITCH, BUFB = KBYTES + 8192;
    const int tid = fresh_tid(), lane = tid & 63, r32 = lane & 31, hi = lane >> 5;
    const int wid = __builtin_amdgcn_readfirstlane(tid >> 6);
    const int kv_s = tid >> 3, d8 = tid & 7;
    const unsigned kst = kv_s * KPITCH + d8 * 16;
    const unsigned vst = KBYTES + ((kv_s >> 2) * 4 + (d8 >> 1)) * 128 + (kv_s & 3) * 32 + (d8 & 1) * 16;
    const unsigned vrd = KBYTES + (hi * 4 + ((lane >> 4) & 1)) * 128 + ((lane & 15) >> 2) * 32 + (lane & 3) * 8;
    const unsigned krd = r32 * KPITCH + hi * 16;
    LAS unsigned* votes = (LAS unsigned*)(lds + 4 * BUFB);
    for (int pi = blockIdx.x; pi < 1024; pi += gridDim.x) {
#pragma unroll 1
        for (int half = 0; half < 2; ++half) {
            const int bh = pi >> 3, sidx = pi & 7, qb = half ? 15 - sidx : sidx;
            const int b = bh >> 4, h = bh & 15;
            const size_t rowbase = (size_t)b * SEQ;
            const int q0 = qb * 256, tq0 = q0 + 32 * wid, t = tq0 + r32;
            const int NP = 2 * (qb + 1);
            bf16x8 qr[4];
#pragma unroll
            for (int d0 = 0; d0 < 4; ++d0) qr[d0] = *(const bf16x8*)(Q + (rowbase + t) * DM + h * 64 + d0 * 16 + hi * 8);
            f32x16 o[2]; o[0] = f32x16{}; o[1] = f32x16{};
            float Rp = 1.f;
            const bf16_t* Kg = K + (rowbase + kv_s) * DM + h * 64 + d8 * 8;
            const bf16_t* Vg = V + (rowbase + kv_s) * DM + h * 64 + d8 * 8;
            u32x4 kreg[2], vreg[2];
#pragma unroll
            for (int s = 0; s < 2; ++s) { kreg[s] = *(const u32x4*)(Kg + (size_t)(2 * (NP - 1) + s) * 64 * DM); vreg[s] = *(const u32x4*)(Vg + (size_t)(2 * (NP - 1) + s) * 64 * DM); }
#pragma unroll
            for (int s = 0; s < 2; ++s) { *(LAS u32x4*)(lds + s * BUFB + kst) = kreg[s]; *(LAS u32x4*)(lds + s * BUFB + vst) = vreg[s]; }
            __syncthreads();
            int cur = 0;
#pragma unroll 1
            for (int jp = NP - 1; jp >= 0; --jp) {
                if (jp > 0) {
#pragma unroll
                    for (int s = 0; s < 2; ++s) { kreg[s] = *(const u32x4*)(Kg + (size_t)(2 * (jp - 1) + s) * 64 * DM); vreg[s] = *(const u32x4*)(Vg + (size_t)(2 * (jp - 1) + s) * 64 * DM); }
                }
                const LAS unsigned char* tb = lds + cur * 2 * BUFB;
                if (64 * (2 * jp + 1) + 63 < tq0) sb_tile2(tb + BUFB, tb, qr, o, Rp, r32, hi, krd, vrd);
                else { sb_tile(tb + BUFB, 2 * jp + 1, qr, o, Rp, t, tq0, r32, hi, krd, vrd); sb_tile(tb, 2 * jp, qr, o, Rp, t, tq0, r32, hi, krd, vrd); }
                if (jp > 0) {
#pragma unroll
                    for (int s = 0; s < 2; ++s) { *(LAS u32x4*)(lds + ((cur ^ 1) * 2 + s) * BUFB + kst) = kreg[s]; *(LAS u32x4*)(lds + ((cur ^ 1) * 2 + s) * BUFB + vst) = vreg[s]; }
                }
                if (lane == 0) votes[cur * 8 + wid] = __all(Rp == 0.f) ? 1u : 0u;
                __syncthreads();
                { const u32x4 v0 = *(const LAS u32x4*)(votes + cur * 8), v1 = *(const LAS u32x4*)(votes + cur * 8 + 4);
                  if ((v0.x & v0.y & v0.z & v0.w & v1.x & v1.y & v1.z & v1.w) != 0u) break; }
                cur ^= 1;
            }
            __syncthreads();
            { LAS unsigned char* stg = lds + 73728 + wid * 4352;
#pragma unroll
              for (int c = 0; c < 2; ++c)
#pragma unroll
                for (int g = 0; g < 4; ++g) { u32x2 w; w.x = pg8::cvt_pk_bf16(o[c][4 * g], o[c][4 * g + 1]); w.y = pg8::cvt_pk_bf16(o[c][4 * g + 2], o[c][4 * g + 3]);
                    *(LAS u32x2*)(stg + r32 * 136 + 64 * c + 16 * g + 8 * hi) = w; }
              LDS_WAIT();
              bf16_t* Ob = O + (rowbase + tq0) * DM + h * 64;
#pragma unroll
              for (int k = 0; k < 4; ++k) { const int pc = lane + 64 * k, rw = pc >> 3, pp = pc & 7;
                  const u32x2 v0 = *(const LAS u32x2*)(stg + rw * 136 + pp * 16), v1 = *(const LAS u32x2*)(stg + rw * 136 + pp * 16 + 8);
                  *(u32x4*)(Ob + (size_t)rw * DM + pp * 8) = (u32x4){v0.x, v0.y, v1.x, v1.y}; }
              LDS_WAIT(); }
        }
    }
}

__device__ __forceinline__ unsigned sortkey(float v) { const unsigned u = __builtin_bit_cast(unsigned, v + 0.f);
    return (u & 0x80000000u) ? ~u : (u | 0x80000000u); }
__device__ __forceinline__ void indexer_phase(const bf16_t* PJ, float* rk, unsigned short* SEL, LAS unsigned char* lds) {
    const int tid = fresh_tid(), lane = tid & 63, r32 = lane & 31, hi = lane >> 5;
    const int wid = __builtin_amdgcn_readfirstlane(tid >> 6);
    { const int gw = blockIdx.x * NWAVE + wid, NGW = gridDim.x * NWAVE;
      for (int t4 = gw; t4 < TOK / 4; t4 += NGW) { const int tok = 4 * t4 + (lane >> 4);
          const u32x4 w = *(const u32x4*)(PJ + (size_t)tok * PROJ_LD + PJ_LAT + 8 * (lane & 15));
          float ss = bflo(w.x) * bflo(w.x) + bfhi(w.x) * bfhi(w.x) + bflo(w.y) * bflo(w.y) + bfhi(w.y) * bfhi(w.y) + bflo(w.z) * bflo(w.z) + bfhi(w.z) * bfhi(w.z) + bflo(w.w) * bflo(w.w) + bfhi(w.w) * bfhi(w.w);
          ss += __shfl_xor(ss, 1); ss += __shfl_xor(ss, 2); ss += __shfl_xor(ss, 4); ss += __shfl_xor(ss, 8);
          if ((lane & 15) == 0) rk[tok] = rsqrtf(ss * (1.f / 128.f) + RMS_EPS); } }
    constexpr int AUX0 = 131072, AUXW = 3072;
    LAS unsigned* hist = (LAS unsigned*)(lds + AUX0 + wid * AUXW);
    LAS unsigned short* listA = (LAS unsigned short*)(lds + AUX0 + wid * AUXW + 2080);
    LAS float* pmm = (LAS float*)(lds + AUX0 + NWAVE * AUXW);
    for (int gl = blockIdx.x; gl < TOK / 8; gl += gridDim.x) {
        const int b = gl >> 9, jj = gl & 511, t0 = (jj < 256 ? jj : 767 - jj) * 8;
        const size_t rowbase = (size_t)b * SEQ;
        const int t = t0 + wid;
        unsigned short* selrow = SEL + (rowbase + t) * 256;
        if (t0 + 7 < 256) {
#pragma unroll
            for (int i = 0; i < 4; ++i) { const int s = lane + 64 * i; selrow[s] = (unsigned short)(s <= t ? s : 0); }
            continue;
        }
        {
            const int g = r32 >> 3, hp = (r32 >> 2) & 1, ii = r32 & 3, tq = 2 * hp + (g >> 1), head = 4 * (g & 1) + ii;
            bf16x8 af[2][4]; float wq[2][2][8];
#pragma unroll
            for (int rt = 0; rt < 2; ++rt) {
                const bf16_t* qp = PJ + (rowbase + t0 + 4 * rt + tq) * PROJ_LD + PJ_QI + head * 64 + hi * 8;
#pragma unroll
                for (int kk = 0; kk < 4; ++kk) af[rt][kk] = *(const bf16x8*)(qp + kk * 16);
#pragma unroll
                for (int qq = 0; qq < 2; ++qq) { const u32x4 w = *(const u32x4*)(PJ + (rowbase + t0 + 4 * rt + 2 * hi + qq) * PROJ_LD + PJ_WI);
                    const float sc = 0.35355339059327373f;
                    wq[rt][qq][0] = bflo(w.x) * sc; wq[rt][qq][1] = bfhi(w.x) * sc; wq[rt][qq][2] = bflo(w.y) * sc; wq[rt][qq][3] = bfhi(w.y) * sc;
                    wq[rt][qq][4] = bflo(w.z) * sc; wq[rt][qq][5] = bfhi(w.z) * sc; wq[rt][qq][6] = bflo(w.w) * sc; wq[rt][qq][7] = bfhi(w.w) * sc; }
            }
            float rmax[2][2], rmin[2][2];
#pragma unroll
            for (int rt = 0; rt < 2; ++rt)
#pragma unroll
                for (int qq = 0; qq < 2; ++qq) { rmax[rt][qq] = -INFINITY; rmin[rt][qq] = INFINITY; }
            const int nkt = (t0 + 8 + 31) >> 5;
            const bf16_t* kbase = PJ + (rowbase + r32) * PROJ_LD + PJ_KI + hi * 8;
            bf16x8 bcur[4], bnxt[4];
            int kt = wid;
#pragma unroll
            for (int kk = 0; kk < 4; ++kk) bcur[kk] = *(const bf16x8*)(kbase + (size_t)(32 * kt) * PROJ_LD + kk * 16);
#pragma unroll 1
            while (kt < nkt) {
                const int kn = kt + NWAVE;
                if (kn < nkt) {
#pragma unroll
                    for (int kk = 0; kk < 4; ++kk) bnxt[kk] = *(const bf16x8*)(kbase + (size_t)(32 * kn) * PROJ_LD + kk * 16);
                }
                const int key = 32 * kt + r32;
#pragma unroll
                for (int rt = 0; rt < 2; ++rt) {
                    f32x16 acc = f32x16{};
#pragma unroll
                    for (int kk = 0; kk < 4; ++kk) acc = __builtin_amdgcn_mfma_f32_32x32x16_bf16(af[rt][kk], bcur[kk], acc, 0, 0, 0);
#pragma unroll
                    for (int qq = 0; qq < 2; ++qq) { float s = 0.f;
#pragma unroll
                        for (int e = 0; e < 8; ++e) s += wq[rt][qq][e] * fmaxf(acc[8 * qq + e], 0.f);
                        ((LAS float*)lds)[(4 * rt + 2 * hi + qq) * 4096 + key] = s;
                        const bool ok = key <= t0 + 4 * rt + 2 * hi + qq;
                        rmax[rt][qq] = fmaxf(rmax[rt][qq], ok ? s : -INFINITY); rmin[rt][qq] = fminf(rmin[rt][qq], ok ? s : INFINITY); }
                }
#pragma unroll
                for (int kk = 0; kk < 4; ++kk) bcur[kk] = bnxt[kk];
                kt = kn;
            }
#pragma unroll
            for (int rt = 0; rt < 2; ++rt)
#pragma unroll
                for (int qq = 0; qq < 2; ++qq) {
#pragma unroll
                    for (int o = 1; o < 32; o <<= 1) { rmax[rt][qq] = fmaxf(rmax[rt][qq], __shfl_xor(rmax[rt][qq], o)); rmin[rt][qq] = fminf(rmin[rt][qq], __shfl_xor(rmin[rt][qq], o)); }
                    if (r32 == 0) { pmm[(wid * 8 + 4 * rt + 2 * hi + qq) * 2] = rmax[rt][qq]; pmm[(wid * 8 + 4 * rt + 2 * hi + qq) * 2 + 1] = rmin[rt][qq]; } }
        }
        __syncthreads();
        {
            const LAS float* row = (const LAS float*)lds + wid * 4096;
            float vmax = -INFINITY, vmin = INFINITY;
#pragma unroll
            for (int w = 0; w < NWAVE; ++w) { vmax = fmaxf(vmax, pmm[(w * 8 + wid) * 2]); vmin = fminf(vmin, pmm[(w * 8 + wid) * 2 + 1]); }
            const int nI4 = (t >> 8) + 1;
            float lo = vmin, sc = (vmax > vmin) ? 511.f / (vmax - vmin) : 0.f;
            float lo0 = 0.f, sc0 = 0.f, lo1 = 0.f, sc1 = 0.f; int b0 = 0, b1 = 0;
            unsigned need = 256u, base = 0u;
            bool by_index = false;
            LAS unsigned* cl = hist;
#define BINL(x, l, s) min((int)(((x) - (l)) * (s)), 511)
#define ACTIVE(x, idx) (((idx) <= t) & ((lev < 1) | (BINL(x, lo0, sc0) == b0)) & ((lev < 2) | (BINL(x, lo1, sc1) == b1)))
#pragma unroll 1
            for (int lev = 0; ; ++lev) {
#pragma unroll
                for (int i = 0; i < 9; ++i) if (lane + 64 * i < 520) hist[lane + 64 * i] = 0u;
                if (lev == 0) {
#pragma unroll 2
                    for (int i = 0; i < nI4; ++i) { const f32x4 x4 = *(const LAS f32x4*)(row + 256 * i + 4 * lane);
#pragma unroll
                        for (int e = 0; e < 4; ++e) { const int idx = 256 * i + 4 * lane + e; const int bn = (idx <= t) ? BINL(x4[e], lo, sc) : 512 + (lane & 7);
                            __hip_atomic_fetch_add(hist + bn, 1u, __ATOMIC_RELAXED, __HIP_MEMORY_SCOPE_WORKGROUP); } }
                } else {
#pragma unroll 2
                for (int i = 0; i < nI4; ++i) { const f32x4 x4 = *(const LAS f32x4*)(row + 256 * i + 4 * lane);
#pragma unroll
                    for (int e = 0; e < 4; ++e) { const int idx = 256 * i + 4 * lane + e; const float ve = by_index ? -(float)idx : x4[e]; const int bn = ACTIVE(x4[e], idx) ? BINL(ve, lo, sc) : 512 + (lane & 7);
                        __hip_atomic_fetch_add(hist + bn, 1u, __ATOMIC_RELAXED, __HIP_MEMORY_SCOPE_WORKGROUP); } }
                }
                LDS_WAIT();
                unsigned c[8]; unsigned lsum = 0;
                { const u32x4 h0 = *(const LAS u32x4*)(hist + 8 * lane), h1 = *(const LAS u32x4*)(hist + 8 * lane + 4);
                  c[0] = h0.x; c[1] = h0.y; c[2] = h0.z; c[3] = h0.w; c[4] = h1.x; c[5] = h1.y; c[6] = h1.z; c[7] = h1.w; }
#pragma unroll
                for (int i = 0; i < 8; ++i) lsum += c[i];
                unsigned sfx = lsum;
#pragma unroll
                for (int o = 1; o < 64; o <<= 1) { const unsigned x = __shfl_down(sfx, o); if (lane + o < 64) sfx += x; }
                unsigned cum = sfx - lsum; int bst = -1; unsigned cab = 0, ceq = 0;
#pragma unroll
                for (int i = 7; i >= 0; --i) { if (cum < need && cum + c[i] >= need) { bst = 8 * lane + i; cab = cum; ceq = c[i]; } cum += c[i]; }
                const unsigned long long bm = __ballot(bst >= 0);
                const int src = __builtin_amdgcn_readfirstlane((int)__builtin_ctzll(bm));
                const int bstar = __builtin_amdgcn_readfirstlane(__shfl(bst, src));
                const unsigned cnt_above = (unsigned)__builtin_amdgcn_readfirstlane((int)__shfl(cab, src)), cnt_eq = (unsigned)__builtin_amdgcn_readfirstlane((int)__shfl(ceq, src));
                need -= cnt_above;
                LDS_WAIT();
                const bool fast = cnt_eq <= 64u;
                unsigned cb2 = 0; float amax = -INFINITY, amin = INFINITY;
                if (lev == 0) {
#pragma unroll 1
                for (int i = 0; i < nI4; ++i) { const f32x4 x4 = *(const LAS f32x4*)(row + 256 * i + 4 * lane);
                    const int idx0 = 256 * i + 4 * lane;
                    bool sv[4], ev[4]; float vv[4]; unsigned ns = 0;
#pragma unroll
                    for (int e = 0; e < 4; ++e) { const int idx = idx0 + e; const bool act = idx <= t; vv[e] = x4[e]; const int bn = BINL(vv[e], lo, sc);
                        sv[e] = act & (bn > bstar); ev[e] = act & (bn == bstar); ns += sv[e] ? 1u : 0u; }
                    const unsigned long long m1 = __ballot(ns & 1u), m2 = __ballot(ns & 2u), m4 = __ballot(ns & 4u);
                    unsigned pos = base + __builtin_amdgcn_mbcnt_hi((unsigned)(m1 >> 32), __builtin_amdgcn_mbcnt_lo((unsigned)m1, 0u))
                                        + 2u * __builtin_amdgcn_mbcnt_hi((unsigned)(m2 >> 32), __builtin_amdgcn_mbcnt_lo((unsigned)m2, 0u))
                                        + 4u * __builtin_amdgcn_mbcnt_hi((unsigned)(m4 >> 32), __builtin_amdgcn_mbcnt_lo((unsigned)m4, 0u));
                    base += (unsigned)__builtin_popcountll(m1) + 2u * (unsigned)__builtin_popcountll(m2) + 4u * (unsigned)__builtin_popcountll(m4);
#pragma unroll
                    for (int e = 0; e < 4; ++e) { listA[sv[e] ? pos : 256u + (unsigned)lane] = (unsigned short)(idx0 + e); pos += sv[e] ? 1u : 0u; }
                    const bool anye = ev[0] | ev[1] | ev[2] | ev[3];
                    if (fast) {
                        if (__ballot(anye) != 0ull) {
#pragma unroll
                            for (int e = 0; e < 4; ++e) { const unsigned long long me = __ballot(ev[e]);
                                if (ev[e]) { const unsigned cp = cb2 + __builtin_amdgcn_mbcnt_hi((unsigned)(me >> 32), __builtin_amdgcn_mbcnt_lo((unsigned)me, 0u)); cl[cp] = (unsigned)(idx0 + e); cl[64 + cp] = __builtin_bit_cast(unsigned, vv[e]); }
                                cb2 += (unsigned)__builtin_popcountll(me); } }
                    } else {
#pragma unroll
                        for (int e = 0; e < 4; ++e) { amax = fmaxf(amax, ev[e] ? vv[e] : -INFINITY); amin = fminf(amin, ev[e] ? vv[e] : INFINITY); }
                    } }
                } else {
#pragma unroll 1
                for (int i = 0; i < nI4; ++i) { const f32x4 x4 = *(const LAS f32x4*)(row + 256 * i + 4 * lane);
                    const int idx0 = 256 * i + 4 * lane;
                    bool sv[4], ev[4]; float vv[4]; unsigned ns = 0;
#pragma unroll
                    for (int e = 0; e < 4; ++e) { const int idx = idx0 + e; const bool act = ACTIVE(x4[e], idx); vv[e] = by_index ? -(float)idx : x4[e]; const int bn = BINL(vv[e], lo, sc);
                        sv[e] = act & (bn > bstar); ev[e] = act & (bn == bstar); ns += sv[e] ? 1u : 0u; }
                    const unsigned long long m1 = __ballot(ns & 1u), m2 = __ballot(ns & 2u), m4 = __ballot(ns & 4u);
                    unsigned pos = base + __builtin_amdgcn_mbcnt_hi((unsigned)(m1 >> 32), __builtin_amdgcn_mbcnt_lo((unsigned)m1, 0u))
                                        + 2u * __builtin_amdgcn_mbcnt_hi((unsigned)(m2 >> 32), __builtin_amdgcn_mbcnt_lo((unsigned)m2, 0u))
                                        + 4u * __builtin_amdgcn_mbcnt_hi((unsigned)(m4 >> 32), __builtin_amdgcn_mbcnt_lo((unsigned)m4, 0u));
                    base += (unsigned)__builtin_popcountll(m1) + 2u * (unsigned)__builtin_popcountll(m2) + 4u * (unsigned)__builtin_popcountll(m4);
#pragma unroll
                    for (int e = 0; e < 4; ++e) { listA[sv[e] ? pos : 256u + (unsigned)lane] = (unsigned short)(idx0 + e); pos += sv[e] ? 1u : 0u; }
                    const bool anye = ev[0] | ev[1] | ev[2] | ev[3];
                    if (fast) {
                        if (__ballot(anye) != 0ull) {
#pragma unroll
                            for (int e = 0; e < 4; ++e) { const unsigned long long me = __ballot(ev[e]);
                                if (ev[e]) { const unsigned cp = cb2 + __builtin_amdgcn_mbcnt_hi((unsigned)(me >> 32), __builtin_amdgcn_mbcnt_lo((unsigned)me, 0u)); cl[cp] = (unsigned)(idx0 + e); cl[64 + cp] = __builtin_bit_cast(unsigned, vv[e]); }
                                cb2 += (unsigned)__builtin_popcountll(me); } }
                    } else {
#pragma unroll
                        for (int e = 0; e < 4; ++e) { amax = fmaxf(amax, ev[e] ? vv[e] : -INFINITY); amin = fminf(amin, ev[e] ? vv[e] : INFINITY); }
                    } }
                }
                if (fast) {
                    LDS_WAIT();
                    const bool have = (unsigned)lane < cnt_eq;
                    const unsigned myi = have ? cl[lane] : 0xffffffffu; const float myv = have ? __builtin_bit_cast(float, cl[64 + lane]) : -INFINITY;
                    unsigned rank = 0;
                    for (unsigned j2 = 0; j2 < cnt_eq; ++j2) { const float vj = __shfl(myv, (int)j2); const unsigned ij = __shfl(myi, (int)j2); rank += (vj > myv || (vj == myv && ij < myi)) ? 1u : 0u; }
                    const bool s = have && rank < need; const unsigned long long m = __ballot(s);
                    if (s) listA[base + __builtin_amdgcn_mbcnt_hi((unsigned)(m >> 32), __builtin_amdgcn_mbcnt_lo((unsigned)m, 0u))] = (unsigned short)myi;
                    break;
                }
#pragma unroll
                for (int o = 1; o < 64; o <<= 1) { amax = fmaxf(amax, __shfl_xor(amax, o)); amin = fminf(amin, __shfl_xor(amin, o)); }
                if (lev < 2 && !by_index) {
                    if (lev == 0) { lo0 = lo; sc0 = sc; b0 = bstar; } else { lo1 = lo; sc1 = sc; b1 = bstar; }
                    if (amax > amin) { lo = amin; sc = 511.f / (amax - amin); }
                    else { by_index = true; lo = -(float)t; sc = 511.f / (float)t; }
                    continue;
                }
                {
                    const int nI = (t >> 6) + 1;
                    const unsigned kmin = sortkey(amin), kmax = sortkey(amax), kdiff = kmin ^ kmax; const int nb = kdiff ? 32 - __builtin_clz(kdiff) : 0;
                    unsigned tau = nb >= 32 ? 0u : ((kmax >> nb) << nb);
#define CAND(x, idx) (ACTIVE(x, idx) && BINL(x, lo, sc) == bstar)
#pragma unroll 1
                    for (int bit = nb - 1; bit >= 0; --bit) { const unsigned trial = tau | (1u << bit); unsigned cnt = 0;
#pragma unroll 2
                        for (int i = 0; i < nI; ++i) { const int idx = lane + 64 * i; const float x = row[idx]; cnt += (CAND(x, idx) && sortkey(x) >= trial) ? 1u : 0u; }
#pragma unroll
                        for (int o = 1; o < 64; o <<= 1) cnt += __shfl_xor(cnt, o);
                        if (cnt >= need) tau = trial; }
                    unsigned cg = 0;
#pragma unroll 2
                    for (int i = 0; i < nI; ++i) { const int idx = lane + 64 * i; const float x = row[idx]; cg += (CAND(x, idx) && sortkey(x) > tau) ? 1u : 0u; }
#pragma unroll
                    for (int o = 1; o < 64; o <<= 1) cg += __shfl_xor(cg, o);
                    unsigned ties = need - cg;
#pragma unroll 1
                    for (int i = 0; i < nI; ++i) { const int idx = lane + 64 * i; const float x = row[idx]; const bool cand = CAND(x, idx); const unsigned kx = sortkey(x);
                        const bool gt = cand && kx > tau, eq = cand && kx == tau; const unsigned long long me = __ballot(eq);
                        const unsigned eoff = __builtin_amdgcn_mbcnt_hi((unsigned)(me >> 32), __builtin_amdgcn_mbcnt_lo((unsigned)me, 0u));
                        const bool s = gt || (eq && eoff < ties); const unsigned long long m = __ballot(s);
                        if (s) listA[base + __builtin_amdgcn_mbcnt_hi((unsigned)(m >> 32), __builtin_amdgcn_mbcnt_lo((unsigned)m, 0u))] = (unsigned short)idx;
                        base += (unsigned)__builtin_popcountll(m); const unsigned ne = (unsigned)__builtin_popcountll(me); ties = ties > ne ? ties - ne : 0u; }
#undef CAND
                    break;
                }
            }
#undef ACTIVE
#undef BINL
            LDS_WAIT();
            *(u32x2*)(selrow + 4 * lane) = *(const LAS u32x2*)(listA + 4 * lane);
        }
        __syncthreads();
    }
}

__device__ __forceinline__ unsigned off_b(unsigned row, unsigned ch) { return 256u * row + 16u * (ch ^ (((row & 3) << 2) | ((row >> 2) & 3))); }
__device__ __forceinline__ void dsa_attn_phase(const bf16_t* PJ, const float* rk, const unsigned short* SEL, const float* biasd, const float* qg, const float* kg, bf16_t* OL, LAS unsigned char* lds) {
    const int tid = fresh_tid(), lane = tid & 63, c16 = lane & 15, G = lane >> 4;
    const int wid = __builtin_amdgcn_readfirstlane(tid >> 6);
    LAS float* biasS = (LAS float*)(lds + 135168);
    for (int e = tid; e < 2048; e += NTHR) biasS[e] = biasd[e];
    if (tid < 16) biasS[2048 + tid] = -INFINITY;
    __syncthreads();
    LAS unsigned char* tile = lds + wid * 16896;
    LAS int* selS = (LAS int*)(tile + 16384);
    LAS float* rS = (LAS float*)(tile + 16384 + 256);
    const int gw = blockIdx.x * NWAVE + wid, NGW = gridDim.x * NWAVE;
    float bmax = -INFINITY;
#pragma unroll 4
    for (int d = G * 32; d < G * 32 + 32; ++d) bmax = fmaxf(bmax, biasS[d * 16 + c16]);
    bmax = fmaxf(bmax, __shfl_xor(bmax, 16)); bmax = fmaxf(bmax, __shfl_xor(bmax, 32));
    u32x4 selreg = (u32x4){0u, 0u, 0u, 0u};
    if (gw < TOK) { const unsigned short* sp = SEL + (size_t)gw * 256 + lane; selreg = (u32x4){sp[0], sp[64], sp[128], sp[192]}; }
#pragma unroll 1
    for (int qi = gw; qi < TOK; qi += NGW) {
        const int b = qi >> 12, t = qi & 4095;
        const size_t rowbase = (size_t)b * SEQ;
        const int count = (t + 1 < 256) ? t + 1 : 256;
        const int nch = (count + 63) >> 6;
        const bf16_t* latb = PJ + rowbase * PROJ_LD + PJ_LAT + c16 * 8;
        int sl = (lane < count) ? (int)selreg[0] : 0;
        float rkv = rk[rowbase + sl];
        u32x4 gr[16];
#pragma unroll
        for (int i = 0; i < 16; ++i) { const int srow = __shfl(sl, 4 * i + G); gr[i] = *(const u32x4*)(latb + (size_t)srow * PROJ_LD); }
        bf16x8 qf[4]; float mshift;
        {
            float qv[4][8]; float ss = 0.f;
#pragma unroll
            for (int kk = 0; kk < 4; ++kk) { const u32x4 w = *(const u32x4*)(PJ + (rowbase + t) * PROJ_LD + c16 * 128 + 32 * kk + 8 * G);
                qv[kk][0] = bflo(w.x); qv[kk][1] = bfhi(w.x); qv[kk][2] = bflo(w.y); qv[kk][3] = bfhi(w.y); qv[kk][4] = bflo(w.z); qv[kk][5] = bfhi(w.z); qv[kk][6] = bflo(w.w); qv[kk][7] = bfhi(w.w);
#pragma unroll
                for (int j = 0; j < 8; ++j) ss += qv[kk][j] * qv[kk][j]; }
            ss += __shfl_xor(ss, 16); ss += __shfl_xor(ss, 32);
            const float rinv = rsqrtf(ss * (1.f / 128.f) + RMS_EPS) * (0.08838834764831845f * LOG2E);
            float qn = 0.f;
#pragma unroll
            for (int kk = 0; kk < 4; ++kk) { const int d = 32 * kk + 8 * G;
                const f32x4 g0 = *(const f32x4*)(qg + d), g1 = *(const f32x4*)(qg + d + 4), h0 = *(const f32x4*)(kg + d), h1 = *(const f32x4*)(kg + d + 4);
                u32x4 w; w.x = pg8::cvt_pk_bf16(qv[kk][0] * rinv * g0[0] * h0[0], qv[kk][1] * rinv * g0[1] * h0[1]); w.y = pg8::cvt_pk_bf16(qv[kk][2] * rinv * g0[2] * h0[2], qv[kk][3] * rinv * g0[3] * h0[3]);
                w.z = pg8::cvt_pk_bf16(qv[kk][4] * rinv * g1[0] * h1[0], qv[kk][5] * rinv * g1[1] * h1[1]); w.w = pg8::cvt_pk_bf16(qv[kk][6] * rinv * g1[2] * h1[2], qv[kk][7] * rinv * g1[3] * h1[3]);
                qf[kk] = __builtin_bit_cast(bf16x8, w);
                qn += bflo(w.x) * bflo(w.x) + bfhi(w.x) * bfhi(w.x) + bflo(w.y) * bflo(w.y) + bfhi(w.y) * bfhi(w.y) + bflo(w.z) * bflo(w.z) + bfhi(w.z) * bfhi(w.z) + bflo(w.w) * bflo(w.w) + bfhi(w.w) * bfhi(w.w); }
            qn += __shfl_xor(qn, 16); qn += __shfl_xor(qn, 32);
            mshift = sqrtf(qn) * 11.313708498984761f * 1.01f + bmax;
        }
        f32x4 o[8];
#pragma unroll
        for (int dt = 0; dt < 8; ++dt) o[dt] = (f32x4){0.f, 0.f, 0.f, 0.f};
        float lrun = 0.f;
        u32x4 selnext = selreg;
#pragma unroll 1
        for (int ch = 0; ch < nch; ++ch) {
            { const bool vk = ch * 64 + lane < count; int dist = t - sl; dist = dist < 0 ? 0 : (dist > 127 ? 127 : dist);
              selS[lane] = vk ? dist * 16 : 2048; rS[lane] = vk ? rkv : 0.f; }
#pragma unroll
            for (int i = 0; i < 16; ++i) *(LAS u32x4*)(tile + off_b(4 * i + G, c16)) = gr[i];
            if (ch + 1 < nch) {
                const unsigned sv = (ch == 0) ? selreg[1] : (ch == 1) ? selreg[2] : selreg[3];
                sl = ((ch + 1) * 64 + lane < count) ? (int)sv : 0;
                rkv = rk[rowbase + sl];
#pragma unroll
                for (int i = 0; i < 16; ++i) { const int srow = __shfl(sl, 4 * i + G); gr[i] = *(const u32x4*)(latb + (size_t)srow * PROJ_LD); }
            } else if (qi + NGW < TOK) {
                const unsigned short* sp = SEL + (size_t)(qi + NGW) * 256 + lane; selnext = (u32x4){sp[0], sp[64], sp[128], sp[192]};
            }
            LDS_WAIT();
            float pl[4][4];
#pragma unroll
            for (int kt4 = 0; kt4 < 4; ++kt4) {
                const unsigned arow = 32 * (kt4 >> 1) + 8 * (c16 >> 2) + 4 * (kt4 & 1) + (c16 & 3);
                f32x4 acc = (f32x4){0.f, 0.f, 0.f, 0.f};
#pragma unroll
                for (int kk = 0; kk < 4; ++kk) { const bf16x8 a = *(const LAS bf16x8*)(tile + off_b(arow, 4 * kk + G)); acc = __builtin_amdgcn_mfma_f32_16x16x32_bf16(a, qf[kk], acc, 0, 0, 0); }
                const int rho = 32 * (kt4 >> 1) + 8 * G + 4 * (kt4 & 1);
                const u32x4 s4 = *(const LAS u32x4*)(selS + rho); const f32x4 r4 = *(const LAS f32x4*)(rS + rho);
#pragma unroll
                for (int reg = 0; reg < 4; ++reg) { const float lg = acc[reg] * r4[reg] + biasS[(int)s4[reg] + c16];
                    pl[kt4][reg] = __builtin_amdgcn_exp2f(lg - mshift); lrun += pl[kt4][reg]; }
            }
            bf16x8 pf[2];
#pragma unroll
            for (int ks = 0; ks < 2; ++ks) { u32x4 w; w.x = pg8::cvt_pk_bf16(pl[2 * ks][0], pl[2 * ks][1]); w.y = pg8::cvt_pk_bf16(pl[2 * ks][2], pl[2 * ks][3]);
                w.z = pg8::cvt_pk_bf16(pl[2 * ks + 1][0], pl[2 * ks + 1][1]); w.w = pg8::cvt_pk_bf16(pl[2 * ks + 1][2], pl[2 * ks + 1][3]); pf[ks] = __builtin_bit_cast(bf16x8, w); }
            const unsigned q4 = (lane & 15) >> 2, p4 = lane & 3;
#pragma unroll
            for (int dt = 0; dt < 8; ++dt) {
#pragma unroll
                for (int ks = 0; ks < 2; ++ks) {
                    const s16x4 lo = __builtin_bit_cast(s16x4, __builtin_amdgcn_ds_read_tr16_b64_v4i16((LAS s16x4*)(tile + off_b(32 * ks + 8 * G + q4, 2 * dt + (p4 >> 1)) + 8 * (p4 & 1))));
                    const s16x4 hh = __builtin_bit_cast(s16x4, __builtin_amdgcn_ds_read_tr16_b64_v4i16((LAS s16x4*)(tile + off_b(32 * ks + 8 * G + 4 + q4, 2 * dt + (p4 >> 1)) + 8 * (p4 & 1))));
                    const bf16x8 vf = (bf16x8){lo[0], lo[1], lo[2], lo[3], hh[0], hh[1], hh[2], hh[3]};
                    o[dt] = __builtin_amdgcn_mfma_f32_16x16x32_bf16(vf, pf[ks], o[dt], 0, 0, 0);
                }
            }
            LDS_WAIT();
        }
        selreg = selnext;
        lrun += __shfl_xor(lrun, 16); lrun += __shfl_xor(lrun, 32);
        const float inv = 1.f / lrun;
        bf16_t* op = OL + (rowbase + t) * 2048 + c16 * 128 + 4 * G;
#pragma unroll
        for (int dt = 0; dt < 8; ++dt) { u32x2 w; w.x = pg8::cvt_pk_bf16(o[dt][0] * inv, o[dt][1] * inv); w.y = pg8::cvt_pk_bf16(o[dt][2] * inv, o[dt][3] * inv); *(u32x2*)(op + 16 * dt) = w; }
    }
}

template <class Epi> __device__ __forceinline__ void run_gemm(LAS unsigned char* lds, const bf16_t* A, const bf16_t* Bt, int N, int K, const Epi& E) {
    pg8::Gemm g{A, Bt, TOK, N, K}; pg8::StaticOrder S; S.init(TOK, N, (int)gridDim.x, (int)blockIdx.x);
    pg8::gemm_phase<Epi, pg8::StaticOrder, true, true>(lds, g, S, E);
}

#define RLX_AGENT __ATOMIC_RELAXED, __HIP_MEMORY_SCOPE_AGENT
#define XB_TMO      128
#define XB_XCNT(j)  (256  + 64 * (j))
#define XB_XSUB(j)  (1280 + 64 * (j))
#define XB_XGEN(j)  (2304 + 64 * (j))
#define XB_TOP      3328
#define XB_TOPGEN   3392
#define XCD_BAR_WORDS 3456
#define XB_SPIN_CAP (1u << 18)

__device__ __forceinline__ unsigned xb_ld(unsigned* p)              { return __hip_atomic_load(p, __ATOMIC_RELAXED, __HIP_MEMORY_SCOPE_AGENT); }
__device__ __forceinline__ unsigned xb_add(unsigned* p, unsigned v) { return __hip_atomic_fetch_add(p, v, __ATOMIC_RELAXED, __HIP_MEMORY_SCOPE_AGENT); }
__device__ __forceinline__ unsigned xb_xcc_id() { return (unsigned)__builtin_amdgcn_s_getreg((3 << 11) | 20) & 0xFu; }
#define XB_SPIN(cond, bar) do { unsigned _sp = 0; while (cond) { __builtin_amdgcn_s_sleep(1); \
    if ((++_sp & 255u) == 0u) { if (xb_ld(&(bar)[XB_TMO])) break; if (_sp > XB_SPIN_CAP) { atomicAdd(&(bar)[XB_TMO], 1u); break; } } } } while (0)

struct XcdBarrier {
    unsigned* bar; unsigned x;
    volatile LAS unsigned* st;
};

__device__ __forceinline__ XcdBarrier xcd_barrier_post(unsigned* bar, volatile LAS unsigned* st) {
    XcdBarrier b; b.bar = bar; b.x = xb_xcc_id(); b.st = st;
    if (threadIdx.x == 0) (void)xb_add(&bar[XB_XCNT(b.x)], 1u);
    return b;
}
__device__ __forceinline__ void xcd_barrier_complete(unsigned* bar, unsigned x, unsigned& nloc, unsigned& nx) {
    const unsigned G = gridDim.x * gridDim.y * gridDim.z;
    unsigned sum, cnt, mine, sp = 0u;
    for (;;) {
        sum = 0u; cnt = 0u; mine = 0u;
#pragma unroll
        for (unsigned j = 0; j < 16; ++j) { const unsigned c = xb_ld(&bar[XB_XCNT(j)]); sum += c; cnt += (c > 0u) ? 1u : 0u; mine = (j == x) ? c : mine; }
        if (sum == G) break;
        __builtin_amdgcn_s_sleep(1);
        if ((++sp & 255u) == 0u) { if (xb_ld(&bar[XB_TMO])) break; if (sp > XB_SPIN_CAP) { atomicAdd(&bar[XB_TMO], 1u); break; } }
    }
    nloc = mine > 0u ? mine : 1u; nx = cnt > 0u ? cnt : 1u;
}

__device__ __forceinline__ void xcd_barrier(const XcdBarrier& b) {
    asm volatile("s_waitcnt vmcnt(0)" ::: "memory");
    __syncthreads();
    if (threadIdx.x == 0) {
        unsigned* bar = b.bar;
        __builtin_amdgcn_s_waitcnt(0);
        unsigned nloc = b.st[0], nx = b.st[1];
        if (nloc == 0u) { xcd_barrier_complete(bar, b.x, nloc, nx); b.st[0] = nloc; b.st[1] = nx; }
        const unsigned old = xb_add(&bar[XB_XSUB(b.x)], 1u);
        const unsigned gen = old / nloc;
        if (old + 1u == (gen + 1u) * nloc) {
            __builtin_amdgcn_fence(__ATOMIC_RELEASE, "agent");
            asm volatile("s_waitcnt vmcnt(0)" ::: "memory");
            const unsigned og = xb_add(&bar[XB_TOP], 1u);
            const unsigned tg = og / nx;
            if (og + 1u == (tg + 1u) * nx) xb_add(&bar[XB_TOPGEN], 1u);
            else XB_SPIN(xb_ld(&bar[XB_TOPGEN]) == tg, bar);
            __builtin_amdgcn_fence(__ATOMIC_ACQUIRE, "agent");
            xb_add(&bar[XB_XGEN(b.x)], 1u);
            asm volatile("s_waitcnt vmcnt(0)" ::: "memory");
        } else {
            XB_SPIN(xb_ld(&bar[XB_XGEN(b.x)]) == gen, bar);
            __builtin_amdgcn_fence(__ATOMIC_ACQUIRE, "agent");
            asm volatile("s_waitcnt vmcnt(0)" ::: "memory");
        }
    }
    __syncthreads();
}

typedef const Params __attribute__((address_space(4)))* KArgs;
#define PHASE_BEGIN { KArgs q = (KArgs)__builtin_amdgcn_kernarg_segment_ptr(); asm volatile("" : "+s"(q)); unsigned char* ws = q->ws; (void)ws;
#define PHASE_END } GRID_SYNC();
#define GRID_SYNC() xcd_barrier(bar)
#define WSP(T, off) ((T*)(ws + (off)))
__global__ void __launch_bounds__(NTHR, 2) mega_fwd(Params p_unused) {
    extern __shared__ __attribute__((aligned(16))) unsigned char lds_raw[];
    LAS unsigned char* lds = (LAS unsigned char*)lds_raw;
    cg::grid_group grid = cg::this_grid();
    volatile LAS unsigned* st = (volatile LAS unsigned*)(lds + LDS_PHASE_BYTES);
    if (threadIdx.x < 4) st[threadIdx.x] = 0u;
    __syncthreads();
    XcdBarrier bar;
    { KArgs q = (KArgs)__builtin_amdgcn_kernarg_segment_ptr(); bar = xcd_barrier_post((unsigned*)(q->ws + WS_BAR), st); }

    PHASE_BEGIN { Params p; for (int i = 0; i < 18; ++i) p.in[i] = q->in[i]; p.out = q->out; p.ws = q->ws; p0_prologue(p, lds); }
        if (q->ws == nullptr) grid.sync();
    PHASE_END
    PHASE_BEGIN { Params p; for (int i = 0; i < 18; ++i) p.in[i] = q->in[i]; p.out = q->out; p.ws = q->ws; p0_weights(p, lds); }
        norm_phase(q->in[0], q->in[4], WSP(float, WS_MOD), 0, 1024, WSP(bf16_t, WS_H)); PHASE_END
    PHASE_BEGIN EpiBf16 E{WSP(bf16_t, WS_A), DM, DM, (size_t)TOK * DM, 0.125f * LOG2E}; run_gemm(lds, WSP(bf16_t, WS_H), WSP(bf16_t, WS_WQKV), 3 * DM, DM, E); PHASE_END
    PHASE_BEGIN bf16_t* RA = WSP(bf16_t, WS_A); sb_attn_phase(RA, RA + (size_t)TOK * DM, RA + (size_t)2 * TOK * DM, WSP(bf16_t, WS_B), lds); PHASE_END
    PHASE_BEGIN EpiResid E{q->in[0], q->out, WSP(float, WS_MOD) + 2048}; run_gemm(lds, WSP(bf16_t, WS_B), WSP(bf16_t, WS_WSBO), DM, DM, E); PHASE_END
    PHASE_BEGIN norm_phase(q->out, q->in[5], WSP(float, WS_MOD), 3072, 4096, WSP(bf16_t, WS_H)); PHASE_END
    PHASE_BEGIN EpiConvGate E{WSP(bf16_t, WS_A), WSP(float, WS_HF), WSP(float, WS_HL), q->in[15], q->in[16]}; run_gemm(lds, WSP(bf16_t, WS_H), WSP(bf16_t, WS_WUP0), FFN2, DM, E); PHASE_END
    PHASE_BEGIN fixup_phase(WSP(float, WS_HF), WSP(float, WS_HL), q->in[15], q->in[16], WSP(bf16_t, WS_A)); PHASE_END
    PHASE_BEGIN EpiResid E{q->out, q->out, WSP(float, WS_MOD) + 5120}; run_gemm(lds, WSP(bf16_t, WS_A), WSP(bf16_t, WS_WDN0), DM, FFN, E); PHASE_END
    PHASE_BEGIN norm_phase(q->out, q->in[4] + DM, WSP(float, WS_MOD) + 8 * 6144, 0, 1024, WSP(bf16_t, WS_H)); PHASE_END
    PHASE_BEGIN EpiBf16 E{WSP(bf16_t, WS_A), PROJ_LD, 0, 0, 1.f}; run_gemm(lds, WSP(bf16_t, WS_H), WSP(bf16_t, WS_WDIN), PROJ_LD, DM, E); PHASE_END
    PHASE_BEGIN indexer_phase(WSP(bf16_t, WS_A), WSP(float, WS_RK), WSP(unsigned short, WS_SEL), lds); PHASE_END
    PHASE_BEGIN dsa_attn_phase(WSP(bf16_t, WS_A), WSP(float, WS_RK), WSP(unsigned short, WS_SEL), WSP(float, WS_BIASD), q->in[9], q->in[10], WSP(bf16_t, WS_B), lds); PHASE_END
    PHASE_BEGIN EpiResid E{q->out, q->out, WSP(float, WS_MOD) + 8 * 6144 + 2048}; run_gemm(lds, WSP(bf16_t, WS_B), WSP(bf16_t, WS_WDO), DM, 2 * DM, E); PHASE_END
    PHASE_BEGIN norm_phase(q->out, q->in[5] + DM, WSP(float, WS_MOD) + 8 * 6144, 3072, 4096, WSP(bf16_t, WS_H)); PHASE_END
    PHASE_BEGIN EpiConvGate E{WSP(bf16_t, WS_A), WSP(float, WS_HF), WSP(float, WS_HL), q->in[15] + 3 * FFN2, q->in[16] + FFN2}; run_gemm(lds, WSP(bf16_t, WS_H), WSP(bf16_t, WS_WUP1), FFN2, DM, E); PHASE_END
    PHASE_BEGIN fixup_phase(WSP(float, WS_HF), WSP(float, WS_HL), q->in[15] + 3 * FFN2, q->in[16] + FFN2, WSP(bf16_t, WS_A)); PHASE_END
    { KArgs q = (KArgs)__builtin_amdgcn_kernarg_segment_ptr(); asm volatile("" : "+s"(q)); unsigned char* ws = q->ws;
      EpiResid E{q->out, q->out, WSP(float, WS_MOD) + 8 * 6144 + 5120}; run_gemm(lds, WSP(bf16_t, WS_A), WSP(bf16_t, WS_WDN1), DM, FFN, E); }
}

extern "C" void kernel_launch(void* const* d_in, const int* in_sizes, int n_in, void* d_out, int out_size, void* d_ws, size_t ws_size, hipStream_t stream) {
    static int grid = 0;
    if (grid == 0) {
        if (n_in != 18 || out_size != TOK * DM || ws_size < WS_END) { fprintf(stderr, "kernel_launch: unexpected shapes (n_in %d, out %d, ws %zu)\n", n_in, out_size, ws_size); grid = -1; return; }
        int dev = 0, cus = 0, per_cu = 0;
        hipGetDevice(&dev);
        hipDeviceGetAttribute(&cus, hipDeviceAttributeMultiprocessorCount, dev);
        if (hipFuncSetAttribute((const void*)mega_fwd, hipFuncAttributeMaxDynamicSharedMemorySize, LDS_BYTES) != hipSuccess) { fprintf(stderr, "kernel_launch: hipFuncSetAttribute failed\n"); grid = -1; return; }
        if (hipOccupancyMaxActiveBlocksPerMultiprocessor(&per_cu, (const void*)mega_fwd, NTHR, LDS_BYTES) != hipSuccess || per_cu < 1) { fprintf(stderr, "kernel_launch: occupancy query says %d\n", per_cu); per_cu = 1; }
        (void)hipGetLastError();
        grid = cus * 1;
        fprintf(stderr, "kernel_launch: grid %d (cus %d, per_cu %d)\n", grid, cus, per_cu);
    }
    if (grid < 0) return;
    Params p{};
    for (int i = 0; i < 18; ++i) p.in[i] = (const float*)d_in[i];
    p.out = (float*)d_out; p.ws = (unsigned char*)d_ws;
    void* args[] = {&p};
    if (hipMemsetAsync((char*)d_ws + WS_BAR, 0, XCD_BAR_WORDS * 4, stream) != hipSuccess) { fprintf(stderr, "kernel_launch: memset failed\n"); return; }
    hipError_t e = hipLaunchCooperativeKernel((const void*)mega_fwd, dim3(grid), dim3(NTHR), args, LDS_BYTES, stream);
    if (e != hipSuccess) fprintf(stderr, "cooperative launch failed: %s (grid %d)\n", hipGetErrorString(e), grid);
}
```
